# Optimizing an MI355X kernel written in HIP

```python
import math
import jax, jax.numpy as jnp
from jax import lax
import numpy as np


D_MODEL = 1024
BATCH = 2
SEQ = 8192
DEPTH = 2

N_META = 16
MIX_WIDTH = D_MODEL
DIFF_WIDTH = MIX_WIDTH // 2
FOX_WIDTH = MIX_WIDTH - DIFF_WIDTH
DIFF_QK_DIM = 64
DIFF_V_DIM = 2 * DIFF_QK_DIM
DIFF_HEADS = DIFF_WIDTH // DIFF_V_DIM
FOX_HEAD_DIM = 64
FOX_HEADS = FOX_WIDTH // FOX_HEAD_DIM
ROPE_THETA = 10000.0
Q_BLOCK = 128
NORM_EPS = 1e-6
SPLITS = (DIFF_HEADS * 2 * DIFF_QK_DIM, DIFF_HEADS * 2 * DIFF_QK_DIM, DIFF_WIDTH, DIFF_WIDTH,
          FOX_WIDTH, FOX_WIDTH, FOX_WIDTH, FOX_WIDTH, FOX_HEADS)
PROJ_WIDTH = sum(SPLITS)

kernel_name = 'hymba_diff_fox_hybrid'


def rms_norm(x, g):
    xf = x.astype(jnp.float32)
    y = xf * lax.rsqrt(jnp.mean(xf * xf, axis=-1, keepdims=True) + NORM_EPS)
    return (y * g.astype(jnp.float32)).astype(x.dtype)


def rope(t, pos):
    half = t.shape[-1] // 2
    inv = ROPE_THETA ** (-jnp.arange(half, dtype=jnp.float32) / half)
    ang = pos.astype(jnp.float32)[:, None] * inv[None, :]
    cos, sin = jnp.cos(ang), jnp.sin(ang)
    tf = t.astype(jnp.float32)
    t1, t2 = tf[..., :half], tf[..., half:]
    return jnp.concatenate([t1 * cos - t2 * sin, t2 * cos + t1 * sin], axis=-1).astype(t.dtype)


def sweep_query_blocks(block_fn, q_parts, pos):
    meta_out = block_fn(tuple(q[:, :, :N_META] for q in q_parts), pos[:N_META])

    def to_blocks(q):
        b, h, _, d = q.shape
        return jnp.moveaxis(q[:, :, N_META:].reshape(b, h, -1, Q_BLOCK, d), 2, 0)

    blocks = tuple(to_blocks(q) for q in q_parts)
    pos_blocks = pos[N_META:].reshape(-1, Q_BLOCK)
    outs = lax.map(lambda a: block_fn(a[0], a[1]), (blocks, pos_blocks))
    nb, b, h, t, dv = outs.shape
    real = jnp.moveaxis(outs, 0, 2).reshape(b, h, nb * t, dv)
    return jnp.concatenate([meta_out, real], axis=2)


def hybrid_layer(h, pos, norm_g, w_in, b_forget, lam_q1, lam_k1, lam_q2, lam_k2,
                 subln_g, w_out, lambda_init):
    bsz, length, _ = h.shape
    u = rms_norm(h, norm_g)
    proj = jnp.einsum('bld,dp->blp', u, w_in)
    split_points = np.cumsum(SPLITS)[:-1].tolist()
    dq, dk, dv, dz, fq, fk, fv, fz, f_logit = jnp.split(proj, split_points, axis=-1)

    def diff_qk(t):
        t = t.reshape(bsz, length, DIFF_HEADS, 2, DIFF_QK_DIM).transpose(3, 0, 2, 1, 4)
        return rope(t[0], pos), rope(t[1], pos)

    q1, q2 = diff_qk(dq)
    k1, k2 = diff_qk(dk)
    v_a = dv.reshape(bsz, length, DIFF_HEADS, DIFF_V_DIM).transpose(0, 2, 1, 3)
    lam = (jnp.exp(jnp.sum(lam_q1.astype(jnp.float32) * lam_k1.astype(jnp.float32)))
           - jnp.exp(jnp.sum(lam_q2.astype(jnp.float32) * lam_k2.astype(jnp.float32)))
           + lambda_init)
    d_scale = DIFF_QK_DIM ** -0.5

    def diff_block(qs, qpos):
        qa, qc = qs
        mask = pos[None, :] <= qpos[:, None]

        def probs(q, k):
            s = jnp.einsum('bhqd,bhkd->bhqk', q, k).astype(jnp.float32) * d_scale
            return jax.nn.softmax(jnp.where(mask, s, -jnp.inf), axis=-1)

        p = probs(qa, k1) - lam * probs(qc, k2)
        return jnp.einsum('bhqk,bhkd->bhqd', p.astype(v_a.dtype), v_a)

    o_a = sweep_query_blocks(diff_block, (q1, q2), pos)
    o_a = rms_norm(o_a, subln_g.reshape(DIFF_HEADS, 1, DIFF_V_DIM)) * (1.0 - lambda_init)
    o_a = o_a.transpose(0, 2, 1, 3).reshape(bsz, length, DIFF_WIDTH)

    def fox_heads(t):
        return t.reshape(bsz, length, FOX_HEADS, FOX_HEAD_DIM).transpose(0, 2, 1, 3)

    q_f, k_f, v_f = fox_heads(fq), fox_heads(fk), fox_heads(fv)
    log_f = jax.nn.log_sigmoid(f_logit.astype(jnp.float32) + b_forget.astype(jnp.float32))
    cum = jnp.cumsum(log_f, axis=1).transpose(0, 2, 1)
    f_scale = FOX_HEAD_DIM ** -0.5

    def fox_block(qs, qpos):
        q, c_q = qs
        mask = pos[None, :] <= qpos[:, None]
        s = (jnp.einsum('bhqd,bhkd->bhqk', q, k_f).astype(jnp.float32) * f_scale
             + c_q - cum[:, :, None, :])
        p = jax.nn.softmax(jnp.where(mask, s, -jnp.inf), axis=-1)
        return jnp.einsum('bhqk,bhkd->bhqd', p.astype(v_f.dtype), v_f)

    o_b = sweep_query_blocks(fox_block, (q_f, cum[..., None]), pos)
    o_b = o_b.transpose(0, 2, 1, 3).reshape(bsz, length, FOX_WIDTH)

    mixed = jnp.concatenate([o_a * jax.nn.silu(dz), o_b * jax.nn.silu(fz)], axis=-1)
    return h + jnp.einsum('blm,md->bld', mixed, w_out)


def setup_inputs(seed: int = 0) -> dict:
    key = jax.random.key(seed)
    ks = jax.random.split(key, 14)
    f32 = jnp.float32
    x = jax.random.normal(ks[0], (BATCH, SEQ, D_MODEL), f32)
    meta_tokens = jax.random.normal(ks[1], (N_META, D_MODEL), f32)
    norm_g = 1.0 + 0.02 * jax.random.normal(ks[2], (DEPTH, D_MODEL), f32)
    w_in = jax.random.normal(ks[3], (DEPTH, D_MODEL, PROJ_WIDTH), f32) * D_MODEL ** -0.5
    b_forget = (jnp.linspace(1.0, 6.0, FOX_HEADS, dtype=f32)[None, :]
                + 0.1 * jax.random.normal(ks[4], (DEPTH, FOX_HEADS), f32))
    lam_q1 = 0.1 * jax.random.normal(ks[5], (DEPTH, DIFF_QK_DIM), f32)
    lam_k1 = 0.1 * jax.random.normal(ks[6], (DEPTH, DIFF_QK_DIM), f32)
    lam_q2 = 0.1 * jax.random.normal(ks[7], (DEPTH, DIFF_QK_DIM), f32)
    lam_k2 = 0.1 * jax.random.normal(ks[8], (DEPTH, DIFF_QK_DIM), f32)
    subln_g = 1.0 + 0.02 * jax.random.normal(ks[9], (DEPTH, DIFF_WIDTH), f32)
    w_out = jax.random.normal(ks[10], (DEPTH, MIX_WIDTH, D_MODEL), f32) * MIX_WIDTH ** -0.5
    final_g = 1.0 + 0.02 * jax.random.normal(ks[11], (D_MODEL,), f32)
    return {'x': x, 'meta_tokens': meta_tokens, 'norm_g': norm_g, 'w_in': w_in,
            'b_forget': b_forget, 'lam_q1': lam_q1, 'lam_k1': lam_k1, 'lam_q2': lam_q2,
            'lam_k2': lam_k2, 'subln_g': subln_g, 'w_out': w_out, 'final_g': final_g}


def reference(x, meta_tokens, norm_g, w_in, b_forget, lam_q1, lam_k1, lam_q2, lam_k2,
              subln_g, w_out, final_g):
    bsz, _, dm = x.shape
    meta = jnp.broadcast_to(meta_tokens.astype(x.dtype)[None], (bsz, N_META, dm))
    h = jnp.concatenate([meta, x], axis=1)
    pos = jnp.arange(h.shape[1], dtype=jnp.int32)
    for layer in range(DEPTH):
        lambda_init = 0.8 - 0.6 * math.exp(-0.3 * layer)
        h = hybrid_layer(h, pos, norm_g[layer], w_in[layer], b_forget[layer],
                         lam_q1[layer], lam_k1[layer], lam_q2[layer], lam_k2[layer],
                         subln_g[layer], w_out[layer], lambda_init)
    return rms_norm(h, final_g)[:, N_META:]
```

```cpp
#include <hip/hip_runtime.h>
#include <hip/hip_cooperative_groups.h>
#include <cstdio>
#include <cstdint>
#include <cmath>
namespace cg = cooperative_groups;

#ifndef MK_SINGLE
#define MK_SINGLE 1
#endif

constexpr int MG = 16384;
constexpr int NB = 2, T = 8192, NMETA = 16, LP = 8256, MV = 2 * LP  , MR = 16640, DM = 1024, NP = 4096, PW = 4104, TPB = LP / 64  , NT64 = MV / 64  ;
constexpr float LOG2E = 1.4426950408889634f;
constexpr float C2 = 0.125f * LOG2E;
constexpr float NORM_EPS = 1e-6f;

__device__ __forceinline__ bool row_valid(int R) { if (R >= MV) return false; const int pp = R >= LP ? R - LP : R; return pp >= 48; }
__device__ __forceinline__ int row_pos(int R) { const int pp = R >= LP ? R - LP : R; return pp - 48; }
__device__ __forceinline__ float* hrow(float* out, float* hside, int R) {
    if (R >= MV) return hside + (size_t)(128 + R - MV) * DM;
    const int b = R >= LP ? 1 : 0, pp = R - b * LP;
    if (pp < 64) return hside + (size_t)(b * 64 + pp) * DM;
    return out + ((size_t)b * T + (pp - 64)) * DM;
}

namespace pg8 {
#define PG8_LAS __attribute__((address_space(3)))
typedef unsigned short bf16_t;
typedef short bf16x8 __attribute__((ext_vector_type(8)));
typedef float f32x4 __attribute__((ext_vector_type(4)));
typedef unsigned u32x4 __attribute__((ext_vector_type(4)));
constexpr int BM = 256, BK = 64, HALF = 128, HTB = HALF * BK * 2  , STAGE_BYTES = 8 * HTB, NXCD = 8, WGM = 8;

__host__ __device__ __forceinline__ int lds_byte(int r, int c) { const int st = (r >> 4) * 2 + (c >> 5), rr = r & 15, cc = c & 31, ob = rr * 64 + cc * 2; return st * 1024 + (ob ^ (((ob >> 9) & 1) << 5)); }
__host__ __device__ __forceinline__ void stage_rc(int b, int& R, int& C) { const int st = b / 1024, sb = b % 1024, swz = sb ^ (((sb >> 9) & 1) << 5); R = (st >> 1) * 16 + swz / 64; C = (st & 1) * 32 + (swz % 64) / 2; }
__host__ __device__ __forceinline__ int perm32(int rho) { const int n = rho >> 4, i = rho & 15; return 8 * (i >> 2) + 4 * n + (i & 3); }

struct Unit { int pm, pn; };
struct Gemm { const bf16_t* A; const bf16_t* Bt; int M, N, K; };

struct StaticOrder {
    int nM, nN, nwg, G, c;
    __host__ __device__ void init(int M, int N, int G_, int c_) { nM = M / BM; nN = N / BM; nwg = nM * nN; G = G_; c = c_; }
    __host__ __device__ bool next(int i, Unit& u) const {
        const long L = (long)i * G + c; if (L >= nwg) return false;
        int wgid = (int)L; { const int q = nwg / NXCD, r = nwg % NXCD, xcd = wgid % NXCD, off = wgid / NXCD; wgid = (xcd < r ? xcd * (q + 1) : r * (q + 1) + (xcd - r) * q) + off; }
        const int nig = WGM * nN, gid = wgid / nig, fm = gid * WGM, gsz = (nM - fm) < WGM ? (nM - fm) : WGM;
        u.pm = fm + ((wgid % nig) % gsz); u.pn = (wgid % nig) / gsz; return true;
    }
    __device__ __forceinline__ void a_ready(const Unit&) const {}
    __device__ __forceinline__ void done(const Unit&) const {}
};


__device__ __forceinline__ unsigned cvt_pk_bf16(float lo, float hi) { unsigned r; asm volatile("v_cvt_pk_bf16_f32 %0, %1, %2" : "=v"(r) : "v"(lo), "v"(hi)); return r; }
typedef unsigned u32x2 __attribute__((ext_vector_type(2)));
struct EpiIn {
    static constexpr bool PERM = true, AFTER_DRAIN = false;
    bf16_t* P; const float* sumsq; const float* rope; unsigned* nrm;
    __device__ __forceinline__ void operator()(const f32x4 (&acc)[2][2][4][2], const Unit& u, int wr, int wc, int fr, int fq) const {
        const int pn = u.pn;
        const int mode = (pn < 4) ? 1 : ((pn == 6 || pn == 7 || pn >= 14) ? 2 : 0);
        const float sc = (pn < 2 || pn == 8 || pn == 9) ? C2 : 1.f;
        const int colb = pn * 256 + wc * 32 + 8 * fq;
        float mxb[2] = {0.f, 0.f};
#pragma unroll
        for (int ai = 0; ai < 2; ++ai)
#pragma unroll
            for (int m = 0; m < 4; ++m) {
                const int row = u.pm * BM + ai * HALF + wr * 64 + m * 16 + fr;
                const float rs = rsqrtf(sumsq[row] * (1.0f / DM) + NORM_EPS) * sc;
                const int bb = row >> 13, tt = row & 8191; const size_t R = (size_t)bb * LP + 64 + tt; const int pos = 16 + tt;
#pragma unroll
                for (int bj = 0; bj < 2; ++bj) {
                    const int col = colb + bj * HALF;
                    f32x4 v0 = acc[ai][bj][m][0] * rs, v1 = acc[ai][bj][m][1] * rs;
                    if (mode == 1) {
                        const int j0 = (col & 63) >> 1;
                        const f32x4* cs = (const f32x4*)(rope + ((size_t)pos * 32 + j0) * 2);
                        const f32x4 a = cs[0], b = cs[1];
                        f32x4 w0, w1;
                        w0[0] = v0[0] * a[0] - v0[1] * a[1]; w0[1] = v0[1] * a[0] + v0[0] * a[1];
                        w0[2] = v0[2] * a[2] - v0[3] * a[3]; w0[3] = v0[3] * a[2] + v0[2] * a[3];
                        w1[0] = v1[0] * b[0] - v1[1] * b[1]; w1[1] = v1[1] * b[0] + v1[0] * b[1];
                        w1[2] = v1[2] * b[2] - v1[3] * b[3]; w1[3] = v1[3] * b[2] + v1[2] * b[3];
                        v0 = w0; v1 = w1;
                    } else if (mode == 2) {
#pragma unroll
                        for (int i = 0; i < 4; ++i) { v0[i] = v0[i] * __builtin_amdgcn_rcpf(1.f + __builtin_amdgcn_exp2f(-v0[i] * LOG2E)); v1[i] = v1[i] * __builtin_amdgcn_rcpf(1.f + __builtin_amdgcn_exp2f(-v1[i] * LOG2E)); }
                    }
                    u32x4 w; w.x = cvt_pk_bf16(v0[0], v0[1]); w.y = cvt_pk_bf16(v0[2], v0[3]); w.z = cvt_pk_bf16(v1[0], v1[1]); w.w = cvt_pk_bf16(v1[2], v1[3]);
                    *(u32x4*)(P + R * NP + col) = w;
                    if (pn >= 8 && pn < 12) { float ss = (v0[0] * v0[0] + v0[1] * v0[1]) + (v0[2] * v0[2] + v0[3] * v0[3]) + (v1[0] * v1[0] + v1[1] * v1[1]) + (v1[2] * v1[2] + v1[3] * v1[3]);
                        ss += __shfl_xor(ss, 16); ss += __shfl_xor(ss, 32); mxb[bj] = fmaxf(mxb[bj], ss); }
                }
            }
        if (pn >= 8 && pn < 12) {
#pragma unroll
            for (int bj = 0; bj < 2; ++bj) { float mx = mxb[bj];
#pragma unroll
                for (int o = 1; o < 16; o <<= 1) mx = fmaxf(mx, __shfl_xor(mx, o));
                if (fr == 0 && fq == 0) atomicMax(nrm + (((pn >= 10) ? 8 : 0) + (pn & 1) * 4 + bj * 2 + (wc >> 1)) * 2 + (wc & 1), __float_as_uint(mx)); }
        }
    }
};
struct EpiOut {
    static constexpr bool PERM = false, AFTER_DRAIN = false;
    const float* base; float* out; bf16_t* hb; float* sumsq_next; int write_hb;
    __device__ __forceinline__ void operator()(const f32x4 (&acc)[2][2][4][2], const Unit& u, int wr, int wc, int fr, int fq) const {
        const int col0 = u.pn * BM + wc * 32 + 4 * fq;
#pragma unroll
        for (int ai = 0; ai < 2; ++ai)
#pragma unroll
            for (int m = 0; m < 4; ++m) {
                const int row = u.pm * BM + ai * HALF + wr * 64 + m * 16 + fr;
                float* hp = out + (size_t)row * DM; const float* bp = base + (size_t)row * DM;
                float ss = 0.f;
#pragma unroll
                for (int bj = 0; bj < 2; ++bj)
#pragma unroll
                    for (int n = 0; n < 2; ++n) {
                        const int c = col0 + bj * HALF + n * 16;
                        const f32x4 hv = *(const f32x4*)(bp + c);
                        f32x4 o = hv + acc[ai][bj][m][n];
                        *(f32x4*)(hp + c) = o;
                        ss += (o[0] * o[0] + o[1] * o[1]) + (o[2] * o[2] + o[3] * o[3]);
                        if (write_hb) { u32x2 w; w.x = cvt_pk_bf16(o[0], o[1]); w.y = cvt_pk_bf16(o[2], o[3]); *(u32x2*)(hb + (size_t)row * DM + c) = w; }
                    }
                ss += __shfl_xor(ss, 16); ss += __shfl_xor(ss, 32);
                if (fq == 0) atomicAdd(sumsq_next + row, ss);
            }
    }
};
struct EpiOutFinal {
    static constexpr bool PERM = false, AFTER_DRAIN = false;
    const float* base; float* out; float* sumsq; unsigned* cnt; const float* fg;
    __device__ __forceinline__ void operator()(f32x4 (&acc)[2][2][4][2], const Unit& u, int wr, int wc, int fr, int fq) const {
        const int col0 = u.pn * BM + wc * 32 + 4 * fq;
#pragma unroll
        for (int ai = 0; ai < 2; ++ai)
#pragma unroll
            for (int m = 0; m < 4; ++m) {
                const int row = u.pm * BM + ai * HALF + wr * 64 + m * 16 + fr;
                const float* bp = base + (size_t)row * DM;
                float ss = 0.f;
#pragma unroll
                for (int bj = 0; bj < 2; ++bj)
#pragma unroll
                    for (int n = 0; n < 2; ++n) {
                        const f32x4 o = *(const f32x4*)(bp + col0 + bj * HALF + n * 16) + acc[ai][bj][m][n];
                        acc[ai][bj][m][n] = o;
                        ss += (o[0] * o[0] + o[1] * o[1]) + (o[2] * o[2] + o[3] * o[3]);
                    }
                ss += __shfl_xor(ss, 16); ss += __shfl_xor(ss, 32);
                if (fq == 0) atomicAdd(sumsq + row, ss);
            }
        asm volatile("s_waitcnt vmcnt(0)" ::: "memory");
        __syncthreads();
        if (threadIdx.x == 0) {
            __hip_atomic_fetch_add(cnt + u.pm, 1u, __ATOMIC_RELAXED, __HIP_MEMORY_SCOPE_AGENT);
            unsigned spins = 0;
            while (__hip_atomic_load(cnt + u.pm, __ATOMIC_RELAXED, __HIP_MEMORY_SCOPE_AGENT) < 4u && ++spins < (1u << 22)) __builtin_amdgcn_s_sleep(1);
        }
        __syncthreads();
#pragma unroll
        for (int ai = 0; ai < 2; ++ai)
#pragma unroll
            for (int m = 0; m < 4; ++m) {
                const int row = u.pm * BM + ai * HALF + wr * 64 + m * 16 + fr;
                const float ssr = __hip_atomic_load(sumsq + row, __ATOMIC_RELAXED, __HIP_MEMORY_SCOPE_AGENT);
                const float r = rsqrtf(ssr * (1.0f / DM) + NORM_EPS);
#pragma unroll
                for (int bj = 0; bj < 2; ++bj)
#pragma unroll
                    for (int n = 0; n < 2; ++n) {
                        const int c = col0 + bj * HALF + n * 16;
                        const f32x4 g = *(const f32x4*)(fg + c);
                        *(f32x4*)(out + (size_t)row * DM + c) = acc[ai][bj][m][n] * r * g;
                    }
            }
    }
};

template <class Epi, class Sched, bool ALIGN_EPI = false, bool SP2 = false>
__device__ __forceinline__ void gemm_phase(PG8_LAS unsigned char* lds, const Gemm g, const Sched& S, const Epi& E) {
    int tid_ = threadIdx.x; asm volatile("" : "+v"(tid_));
    const int tid = tid_, wid = __builtin_amdgcn_readfirstlane(tid >> 6), lane = tid & 63, wr = wid >> 2, wc = wid & 3, fr = lane & 15, fq = lane >> 4;
    const int K = g.K, nt = K / BK;
    unsigned voffA[2], voffB[2];
#pragma unroll
    for (int i = 0; i < 2; ++i) { int R, C; stage_rc(tid * 16 + i * 8192, R, C); const int Rb = Epi::PERM ? ((R & ~31) + perm32(R & 31)) : R;
        voffA[i] = (unsigned)(R * K + C) * 2u; voffB[i] = (unsigned)(Rb * K + C) * 2u; }
    const size_t kstep = (size_t)(BK * 2);
    const size_t hstep = (size_t)HALF * K * 2;
    const size_t tstep = 2 * hstep;
    const unsigned ldsw = (unsigned)wid * 1024u;
    const int aoff = lds_byte(wr * 64 + fr, fq * 8), boff = lds_byte(wc * 32 + fr, fq * 8);
#define PG8_SA(b, h) (((b) * 2 + (h)) * HTB)
#define PG8_SB(b, h) ((4 + (b) * 2 + (h)) * HTB)
#define PG8_STAGE(bufoff, gbase, voff) do { _Pragma("unroll") for (int _i = 0; _i < 2; ++_i) \
        __builtin_amdgcn_global_load_lds((const unsigned*)((const char*)(gbase) + (voff)[_i]), (PG8_LAS unsigned*)(lds + (bufoff) + ldsw + _i * 8192), 16, 0, 0); } while (0)
#define PG8_LDA(dst, b, h) do { _Pragma("unroll") for (int m = 0; m < 4; ++m) _Pragma("unroll") for (int k = 0; k < 2; ++k) dst[m][k] = *(const PG8_LAS bf16x8*)(lds + PG8_SA(b, h) + aoff + m * 2048 + k * 1024); } while (0)
#define PG8_LDB(dst, b, h) do { _Pragma("unroll") for (int n = 0; n < 2; ++n) _Pragma("unroll") for (int k = 0; k < 2; ++k) dst[n][k] = *(const PG8_LAS bf16x8*)(lds + PG8_SB(b, h) + boff + n * 2048 + k * 1024); } while (0)
#define PG8_MMA(ai, bj, At, Bt) do { __builtin_amdgcn_s_setprio(1); _Pragma("unroll") for (int m = 0; m < 4; ++m) _Pragma("unroll") for (int n = 0; n < 2; ++n) _Pragma("unroll") for (int k = 0; k < 2; ++k) \
        acc[ai][bj][m][n] = __builtin_amdgcn_mfma_f32_16x16x32_bf16(Bt[n][k], At[m][k], acc[ai][bj][m][n], 0, 0, 0); __builtin_amdgcn_s_setprio(0); } while (0)
#define PG8_WAIT_V(n) asm volatile("s_waitcnt vmcnt(" #n ")" ::: "memory")
#define PG8_WAIT_L(n) asm volatile("s_waitcnt lgkmcnt(" #n ")" ::: "memory")
#define PG8_BAR __builtin_amdgcn_s_barrier()
#define PG8_SCHED __builtin_amdgcn_sched_barrier(0)
    Unit cur, nxt; int ui = 0;
    if (!S.next(0, cur)) return;
    f32x4 acc[2][2][4][2];
#pragma unroll
    for (int a = 0; a < 2; ++a)
#pragma unroll
        for (int b = 0; b < 2; ++b)
#pragma unroll
            for (int m = 0; m < 4; ++m)
#pragma unroll
                for (int n = 0; n < 2; ++n) acc[a][b][m][n] = (f32x4){0.f, 0.f, 0.f, 0.f};
    bf16x8 At[4][2], B0[2][2], B1[2][2];
    const char* cA = (const char*)g.A + (size_t)cur.pm * tstep; const char* cB = (const char*)g.Bt + (size_t)cur.pn * tstep;
    S.a_ready(cur);
    if constexpr (SP2) {
        PG8_STAGE(PG8_SB(0, 0), cB, voffB); PG8_STAGE(PG8_SB(0, 1), cB + hstep, voffB); PG8_STAGE(PG8_SA(0, 0), cA, voffA); PG8_STAGE(PG8_SA(0, 1), cA + hstep, voffA);
        if (wr == 1) PG8_BAR;
        PG8_WAIT_V(2); PG8_BAR;
        PG8_STAGE(PG8_SB(1, 0), cB + kstep, voffB); PG8_STAGE(PG8_SA(1, 0), cA + kstep, voffA); PG8_STAGE(PG8_SB(1, 1), cB + hstep + kstep, voffB);
        PG8_WAIT_V(6); PG8_BAR;
    } else {
        PG8_STAGE(PG8_SB(0, 0), cB, voffB); PG8_STAGE(PG8_SA(0, 0), cA, voffA); PG8_STAGE(PG8_SB(0, 1), cB + hstep, voffB); PG8_STAGE(PG8_SA(0, 1), cA + hstep, voffA);
        if (wr == 1) PG8_BAR;
        PG8_WAIT_V(4); PG8_BAR;
        PG8_STAGE(PG8_SB(1, 0), cB + kstep, voffB); PG8_STAGE(PG8_SA(1, 0), cA + kstep, voffA); PG8_STAGE(PG8_SB(1, 1), cB + hstep + kstep, voffB);
        PG8_WAIT_V(6); PG8_BAR;
    }
    for (;;) {
        const bool has_next = S.next(ui + 1, nxt);
        const char* nA = has_next ? (const char*)g.A + (size_t)nxt.pm * tstep : cA; const char* nB = has_next ? (const char*)g.Bt + (size_t)nxt.pn * tstep : cB;
        for (int t = 0; t < nt; t += 2) {
            const bool last = (t == nt - 2);
            const char* a1 = cA + (size_t)(t + 1) * kstep;
            const char* a2 = last ? nA : cA + (size_t)(t + 2) * kstep; const char* b2 = last ? nB : cB + (size_t)(t + 2) * kstep;
            const char* a3 = a2 + kstep; const char* b3 = b2 + kstep;
            if (last && has_next) S.a_ready(nxt);
            if constexpr (SP2) {
            PG8_LDB(B0, 0, 0); PG8_LDB(B1, 0, 1); PG8_SCHED; PG8_LDA(At, 0, 0); PG8_STAGE(PG8_SA(1, 1), a1 + hstep, voffA);
            PG8_WAIT_V(8); PG8_WAIT_L(0); PG8_BAR; PG8_MMA(0, 0, At, B0); PG8_MMA(0, 1, At, B1); PG8_BAR; PG8_SCHED;
            PG8_LDA(At, 0, 1); PG8_STAGE(PG8_SB(0, 0), b2, voffB); PG8_STAGE(PG8_SB(0, 1), b2 + hstep, voffB); PG8_STAGE(PG8_SA(0, 0), a2, voffA);
            PG8_WAIT_V(8); PG8_WAIT_L(0); PG8_BAR; PG8_MMA(1, 0, At, B0); PG8_MMA(1, 1, At, B1); PG8_BAR; PG8_SCHED;
            PG8_LDB(B0, 1, 0); PG8_LDB(B1, 1, 1); PG8_SCHED; PG8_LDA(At, 1, 0); PG8_STAGE(PG8_SA(0, 1), a2 + hstep, voffA);
            PG8_WAIT_V(8); PG8_WAIT_L(0); PG8_BAR; PG8_MMA(0, 0, At, B0); PG8_MMA(0, 1, At, B1); PG8_BAR; PG8_SCHED;
            PG8_LDA(At, 1, 1); PG8_STAGE(PG8_SB(1, 0), b3, voffB); PG8_STAGE(PG8_SB(1, 1), b3 + hstep, voffB); PG8_STAGE(PG8_SA(1, 0), a3, voffA);
            PG8_WAIT_V(8); PG8_WAIT_L(0); PG8_BAR; PG8_MMA(1, 0, At, B0); PG8_MMA(1, 1, At, B1); PG8_BAR; PG8_SCHED;
            } else {
            PG8_LDB(B0, 0, 0); PG8_SCHED; PG8_LDA(At, 0, 0); PG8_STAGE(PG8_SA(1, 1), a1 + hstep, voffA);
            PG8_WAIT_L(8); PG8_BAR; PG8_WAIT_L(0); PG8_MMA(0, 0, At, B0); PG8_BAR; PG8_SCHED;
            PG8_LDB(B1, 0, 1); PG8_STAGE(PG8_SB(0, 0), b2, voffB);
            PG8_BAR; PG8_WAIT_L(0); PG8_MMA(0, 1, At, B1); PG8_BAR;
            PG8_LDA(At, 0, 1); PG8_STAGE(PG8_SA(0, 0), a2, voffA);
            PG8_BAR; PG8_WAIT_L(0); PG8_MMA(1, 0, At, B0); PG8_BAR; PG8_SCHED;
            PG8_STAGE(PG8_SB(0, 1), b2 + hstep, voffB);
            PG8_WAIT_V(6); PG8_BAR; PG8_MMA(1, 1, At, B1); PG8_BAR;
            PG8_LDB(B0, 1, 0); PG8_SCHED; PG8_LDA(At, 1, 0); PG8_STAGE(PG8_SA(0, 1), a2 + hstep, voffA);
            PG8_WAIT_L(8); PG8_BAR; PG8_WAIT_L(0); PG8_MMA(0, 0, At, B0); PG8_BAR; PG8_SCHED;
            PG8_LDB(B1, 1, 1); PG8_STAGE(PG8_SB(1, 0), b3, voffB);
            PG8_BAR; PG8_WAIT_L(0); PG8_MMA(0, 1, At, B1); PG8_BAR;
            PG8_LDA(At, 1, 1); PG8_STAGE(PG8_SA(1, 0), a3, voffA);
            PG8_BAR; PG8_WAIT_L(0); PG8_MMA(1, 0, At, B0); PG8_BAR; PG8_SCHED;
            PG8_STAGE(PG8_SB(1, 1), b3 + hstep, voffB);
            PG8_WAIT_V(6); PG8_BAR; PG8_MMA(1, 1, At, B1); PG8_BAR;
            }
        }
        if constexpr (ALIGN_EPI) { if (wr == 0) PG8_BAR; }
        if constexpr (!Epi::AFTER_DRAIN) { E(acc, cur, wr, wc, fr, fq); S.done(cur); }
        if (!has_next) break;
#pragma unroll
        for (int a = 0; a < 2; ++a)
#pragma unroll
            for (int b = 0; b < 2; ++b)
#pragma unroll
                for (int m = 0; m < 4; ++m)
#pragma unroll
                    for (int n = 0; n < 2; ++n) acc[a][b][m][n] = (f32x4){0.f, 0.f, 0.f, 0.f};
        cur = nxt; cA = nA; cB = nB; ++ui;
        if constexpr (ALIGN_EPI) { if (wr == 1) PG8_BAR; }
    }
    PG8_WAIT_V(0);
    if constexpr (!ALIGN_EPI) { if (wr == 0) PG8_BAR; }
    PG8_BAR;
    if constexpr (Epi::AFTER_DRAIN) { E.fused(acc, cur, wr, wc, fr, fq, lds, wid, lane); S.done(cur); }
#undef PG8_SA
#undef PG8_SB
#undef PG8_STAGE
#undef PG8_LDA
#undef PG8_LDB
#undef PG8_MMA
#undef PG8_WAIT_V
#undef PG8_WAIT_L
#undef PG8_BAR
#undef PG8_SCHED
}
}

#define LAS __attribute__((address_space(3)))
typedef LAS unsigned char* ldsp;
typedef unsigned short bf16;
typedef short bf16x8 __attribute__((ext_vector_type(8)));
typedef short s16x4 __attribute__((ext_vector_type(4)));
typedef float f32x16 __attribute__((ext_vector_type(16)));
typedef float f32x4 __attribute__((ext_vector_type(4)));
typedef float f32x2 __attribute__((ext_vector_type(2)));
typedef unsigned u32x4 __attribute__((ext_vector_type(4)));
typedef unsigned u32x2 __attribute__((ext_vector_type(2)));
typedef __bf16 bf16x2_t __attribute__((ext_vector_type(2)));
__device__ __forceinline__ unsigned cvtpk(float lo, float hi) { f32x2 v = {lo, hi}; bf16x2_t b = __builtin_convertvector(v, bf16x2_t); return __builtin_bit_cast(unsigned, b); }
__device__ __forceinline__ float bf_lo(unsigned u) { return __uint_as_float(u << 16); }
__device__ __forceinline__ float bf_hi(unsigned u) { return __uint_as_float(u & 0xffff0000u); }
__device__ __forceinline__ float swap32_max(float m) { auto rr = __builtin_amdgcn_permlane32_swap(__float_as_uint(m), __float_as_uint(m), false, false); return fmaxf(__uint_as_float(rr[0]), __uint_as_float(rr[1])); }
__device__ __forceinline__ float swap32_sum(float m) { auto rr = __builtin_amdgcn_permlane32_swap(__float_as_uint(m), __float_as_uint(m), false, false); return __uint_as_float(rr[0]) + __uint_as_float(rr[1]); }
__device__ __forceinline__ int crow(int r, int hi) { return (r & 3) + 8 * (r >> 2) + 4 * hi; }
typedef short v4i16_t __attribute__((ext_vector_type(4)));
__device__ __forceinline__ s16x4 vtr(ldsp p) { return __builtin_bit_cast(s16x4, __builtin_amdgcn_ds_read_tr16_b64_v4i16((LAS v4i16_t*)p)); }
__device__ __forceinline__ float wave_sum(float v) {
#pragma unroll
    for (int o = 1; o < 64; o <<= 1) v += __shfl_xor(v, o);
    return v;
}

constexpr size_t MiB = 1u << 20;
constexpr size_t WS_CTL = 0;
constexpr size_t WS_LAM = 4096;
constexpr size_t WS_UNITS = 8192;
constexpr size_t WS_BAR = 32 * 1024;
constexpr size_t WS_SUMSQ = 64 * 1024;
constexpr size_t WS_CUMTOT = 512 * 1024;
constexpr size_t WS_CUMLOC = 1 * MiB;
constexpr size_t WS_HSIDE = 2 * MiB;
constexpr size_t WS_ROPE = 3 * MiB;
constexpr size_t WS_WIN = 6 * MiB;
constexpr size_t WS_WOUT = 22 * MiB;
constexpr size_t WS_HB = 26 * MiB;
constexpr size_t WS_MIX = 59 * MiB;
constexpr size_t WS_P = 92 * MiB;
constexpr size_t WS_END = 223 * MiB;
static_assert(WS_HB + (size_t)MR * DM * 2 <= WS_MIX && WS_MIX + (size_t)MR * DM * 2 <= WS_P && WS_P + (size_t)MR * NP * 2 <= WS_END, "ws map");
constexpr int N_DIFF_UNITS = 8 * 65, N_FOX_UNITS = 16 * 33, N_UNITS = N_DIFF_UNITS + N_FOX_UNITS;

constexpr int LDS_BYTES = 147456;
constexpr int LDS_PREF = 132 * 1024, LDS_MISC = 133 * 1024;

struct Frame {
    const float *x, *meta, *norm_g, *w_in, *b_forget, *lq1, *lk1, *lq2, *lk2, *subln_g, *w_out, *final_g;
    float* out; unsigned char* ws;
    unsigned* ctl; float* lam; int* units; float* sumsq; float* cumtot; float* cumloc; float* hside; float* rope;
    bf16 *win_t, *wout_t, *hb, *mix, *P, *mixm;
    ldsp lds; int tid, lane, wave, G, bid;
};

__device__ __forceinline__ unsigned f2bf(float f) { unsigned u = __float_as_uint(f); return (u + 0x7fffu + ((u >> 16) & 1u)) >> 16; }
__device__ __forceinline__ unsigned pk2(float lo, float hi) { return f2bf(lo) | (f2bf(hi) << 16); }
__device__ __forceinline__ void transpose_item(const float* W, int ldw, bool ropemap, const float* g, bf16* WT, int nN, LAS float* scr, int item, int lane) {
    const int nblk = nN / 32, kb = item / nblk, nb = item % nblk, k0 = 64 * kb, n0 = 32 * nb;
    const int n = n0 + (lane & 31);
    int col = n; if (ropemap && n < 1024) { const int p = n & 63; col = (n & ~63) + (p >> 1) + 32 * (p & 1); }
    float wv_[32];
#pragma unroll
    for (int i = 0; i < 32; ++i) { const int kk = 2 * i + (lane >> 5); wv_[i] = W[(size_t)(k0 + kk) * ldw + col]; }
#pragma unroll
    for (int i = 0; i < 32; ++i) { const int kk = 2 * i + (lane >> 5); const float gv = g ? g[k0 + kk] : 1.f; scr[kk * 33 + (lane & 31)] = wv_[i] * gv; }
    asm volatile("s_waitcnt lgkmcnt(0)" ::: "memory");
    const int c = lane & 7;
#pragma unroll
    for (int j = 0; j < 4; ++j) { const int nn = (lane >> 3) + 8 * j; const LAS float* s = scr + (8 * c) * 33 + nn;
        u32x4 o; o.x = pk2(s[0 * 33], s[1 * 33]); o.y = pk2(s[2 * 33], s[3 * 33]); o.z = pk2(s[4 * 33], s[5 * 33]); o.w = pk2(s[6 * 33], s[7 * 33]);
        *(u32x4*)(WT + (size_t)(n0 + nn) * DM + k0 + 8 * c) = o; }
    asm volatile("s_waitcnt lgkmcnt(0)" ::: "memory");
}
__device__ __forceinline__ int unit_cost(int u, const float* bfg) {
    if (u < N_DIFF_UNITS) { const int qi = u % 65; return (qi == 0 ? 1 : 1 + 2 * qi) * 4; }
    const int v = u - N_DIFF_UNITS, qi = v % 33, h = (v / 33) & 7;
    const float rate = 1.44f * 1.65f * log1pf(expf(-bfg[h]));
    const int wt = 6 + (int)(95.0f / (64.0f * rate));
    const int full = (qi == 0 ? 1 : 1 + 4 * qi);
    return (full < wt ? full : wt) * 3;
}
__device__ __forceinline__ void p0_prologue(Frame& F) {
    const int gw = F.bid * 8 + F.wave, NGW = F.G * 8, gt = F.bid * 512 + F.tid, NGT = F.G * 512;
    LAS float* scr = (LAS float*)(F.lds + F.wave * 16384);
    constexpr int I_IN = 16 * (NP / 32), I_OUT = 16 * (DM / 32);
    for (int it = gw; it < 2 * (I_IN + I_OUT); it += NGW) {
        int r = it; const int l = r / (I_IN + I_OUT); r -= l * (I_IN + I_OUT);
        if (r < I_IN) transpose_item(F.w_in + (size_t)l * DM * PW, PW, true, F.norm_g + l * DM, F.win_t + (size_t)l * NP * DM, NP, scr, r, F.lane);
        else transpose_item(F.w_out + (size_t)l * DM * DM, DM, false, nullptr, F.wout_t + (size_t)l * DM * DM, DM, scr, r - I_IN, F.lane);
    }
    for (int m0 = gw * 4; m0 < MG; m0 += NGW * 4) {
        f32x4 v[4][4];
#pragma unroll
        for (int q = 0; q < 4; ++q)
#pragma unroll
            for (int j = 0; j < 4; ++j) v[q][j] = *(const f32x4*)(F.x + (size_t)(m0 + q) * DM + 4 * F.lane + 256 * j);
#pragma unroll
        for (int q = 0; q < 4; ++q) {
            const int m = m0 + q; float ss = 0.f;
#pragma unroll
            for (int j = 0; j < 4; ++j) {
                u32x2 w; w.x = pk2(v[q][j][0], v[q][j][1]); w.y = pk2(v[q][j][2], v[q][j][3]);
                *(u32x2*)(F.hb + (size_t)m * DM + 4 * F.lane + 256 * j) = w;
                ss += (v[q][j][0] * v[q][j][0] + v[q][j][1] * v[q][j][1]) + (v[q][j][2] * v[q][j][2] + v[q][j][3] * v[q][j][3]);
            }
            ss = wave_sum(ss);
            if (F.lane == 0) { F.sumsq[m] = ss; F.sumsq[MG + m] = 0.f; F.sumsq[2 * MG + m] = 0.f; }
        }
    }
    for (int i = gt; i < NMETA * DM; i += NGT) F.hside[i] = F.meta[i];
    for (int i = gt; i < 2 * 48 * (NP / 8); i += NGT) { const int rr = i / (NP / 8), c8 = i % (NP / 8); const int R = (rr / 48) * LP + (rr % 48);
        *(u32x4*)(F.P + (size_t)R * NP + c8 * 8) = (u32x4){0u, 0u, 0u, 0u}; }
    for (int i = gt; i < 8208 * 32; i += NGT) {
        const int pos = i >> 5, j = i & 31;
        const double inv = exp2(-(double)j * (13.287712379549449 / 32.0));
        const double ang = (double)pos * inv;
        double s, c; sincos(ang, &s, &c);
        F.rope[2 * i] = (float)c; F.rope[2 * i + 1] = (float)s;
    }
    if (F.bid == 0) {
        F.ctl[F.tid] = 0u;
        if (F.tid < 2) {
            const int l = F.tid; float s1 = 0.f, s2 = 0.f;
            for (int i = 0; i < 64; ++i) { s1 += F.lq1[l * 64 + i] * F.lk1[l * 64 + i]; s2 += F.lq2[l * 64 + i] * F.lk2[l * 64 + i]; }
            const float li = 0.8f - 0.6f * expf(-0.3f * (float)l);
            F.lam[l] = expf(s1) - expf(s2) + li;
        }
    }
    for (int ul = gw; ul < 2 * N_UNITS; ul += NGW) {
        const int l = ul / N_UNITS, u = ul - l * N_UNITS; const float* bfg = F.b_forget + l * 8;
        const int cu = unit_cost(u, bfg); int cnt = 0;
        for (int v = F.lane; v < N_UNITS; v += 64) { const int cv = unit_cost(v, bfg); cnt += (cv > cu || (cv == cu && v < u)) ? 1 : 0; }
#pragma unroll
        for (int o = 1; o < 64; o <<= 1) cnt += __shfl_xor(cnt, o);
        if (F.lane == 0) F.units[l * N_UNITS + cnt] = u;
    }
}

__device__ __forceinline__ void forget_item(Frame& F, int layer, int tile) {
    const float* W = F.w_in + (size_t)layer * DM * PW + 4096; const float* g = F.norm_g + layer * DM; const float* bfg = F.b_forget + layer * 8;
    ldsp wl = F.lds;
    LAS float* lf = (LAS float*)(F.lds + 40960);
#pragma unroll
    for (int q = 0; q < 2; ++q) { const int kk = F.tid + 512 * q; const float gv = g[kk];
        const f32x4 a = *(const f32x4*)(W + (size_t)kk * PW) * gv, b = *(const f32x4*)(W + (size_t)kk * PW + 4) * gv;
        *(LAS f32x4*)(wl + (kk >> 2) * 144 + (kk & 3) * 32) = a; *(LAS f32x4*)(wl + (kk >> 2) * 144 + (kk & 3) * 32 + 16) = b; }
    __syncthreads();
    const int row_l = F.tid >> 3, kp = F.tid & 7;
    const int fb = tile >> 7, fj = tile & 127; const size_t R0 = (size_t)fb * LP + 64 + 64 * fj;
    const float* xp = (layer == 0 ? F.x : (const float*)F.out) + ((size_t)tile * 64 + row_l) * DM;
    float acc[8] = {0.f, 0.f, 0.f, 0.f, 0.f, 0.f, 0.f, 0.f}; float ss = 0.f;
#pragma unroll 1
    for (int bt = 0; bt < 4; ++bt) {
        f32x4 xv[8];
#pragma unroll
        for (int i = 0; i < 8; ++i) xv[i] = *(const f32x4*)(xp + 4 * (kp + 8 * (bt * 8 + i)));
#pragma unroll
        for (int i = 0; i < 8; ++i) { ldsp wg = wl + (kp + 8 * (bt * 8 + i)) * 144;
#pragma unroll
            for (int e = 0; e < 4; ++e) { const float xe = xv[i][e]; ss += xe * xe;
                const f32x4 wa = *(LAS f32x4*)(wg + e * 32), wb = *(LAS f32x4*)(wg + e * 32 + 16);
                acc[0] += xe * wa[0]; acc[1] += xe * wa[1]; acc[2] += xe * wa[2]; acc[3] += xe * wa[3];
                acc[4] += xe * wb[0]; acc[5] += xe * wb[1]; acc[6] += xe * wb[2]; acc[7] += xe * wb[3]; } }
    }
#pragma unroll
    for (int o = 1; o < 8; o <<= 1) { ss += __shfl_xor(ss, o);
#pragma unroll
        for (int j = 0; j < 8; ++j) acc[j] += __shfl_xor(acc[j], o); }
    float mine = acc[0];
#pragma unroll
    for (int j = 1; j < 8; ++j) mine = (kp == j) ? acc[j] : mine;
    {
        const float xl = mine * rsqrtf(ss * (1.0f / DM) + NORM_EPS) + bfg[kp];
        float v = fminf(xl, 0.f) - log1pf(expf(-fabsf(xl)));
        lf[row_l * 8 + kp] = v;
    }
    __syncthreads();
    if (F.wave == 0) {
        const int seg = F.lane >> 3, j = F.lane & 7;
        float vals[8]; float run = 0.f;
#pragma unroll
        for (int i = 0; i < 8; ++i) { run += lf[(seg * 8 + i) * 8 + j]; vals[i] = run; }
        float inc = run;
#pragma unroll
        for (int o = 8; o < 64; o <<= 1) { const float t_ = __shfl_up(inc, o); if (F.lane >= o) inc += t_; }
        const float excl = inc - run;
#pragma unroll
        for (int i = 0; i < 8; ++i) F.cumloc[(R0 + seg * 8 + i) * 8 + j] = (excl + vals[i]) * LOG2E;
        if (seg == 7) F.cumtot[(fb * TPB + 1 + fj) * 8 + j] = inc * LOG2E;
    }
    __syncthreads();
}

template <int MODE>
__device__ __forceinline__ void meta_item(Frame& F, int layer, int item) {
    LAS float* xT = (LAS float*)(F.lds);
    LAS float* red = (LAS float*)(F.lds + 65536);
    LAS float* rr = (LAS float*)(F.lds + 98304);
    LAS float* lfm = (LAS float*)(F.lds + 98304 + 256);
    const float* W = MODE == 0 ? F.w_in + (size_t)layer * DM * PW : F.w_out + (size_t)layer * DM * DM;
    const int ldw = MODE == 0 ? PW : DM;
    const float* g = F.norm_g + layer * DM;
    for (int idx = F.tid; idx < NMETA * DM; idx += 512) { const int row = idx >> 10, k = idx & 1023;
        float v; if (MODE == 0) v = F.hside[idx]; else v = __uint_as_float((unsigned)F.mixm[idx] << 16);
        xT[k * 16 + row] = v; }
    __syncthreads();
    if (MODE == 0) {
        const int row = F.tid >> 5, l32 = F.tid & 31; float ss = 0.f;
#pragma unroll 8
        for (int i = 0; i < 32; ++i) { const float v = xT[(l32 + 32 * i) * 16 + row]; ss += v * v; }
#pragma unroll
        for (int o = 1; o < 32; o <<= 1) ss += __shfl_xor(ss, o);
        if (l32 == 0) rr[row] = rsqrtf(ss * (1.0f / DM) + NORM_EPS);
    }
    const int c = F.tid & 15, ks = F.tid >> 4;
    const int n = item * 16 + c;
    int col = n; bool colok = true;
    if (MODE == 0) { if (n < 1024) { const int p = n & 63; col = (n & ~63) + (p >> 1) + 32 * (p & 1); } colok = n < PW; if (!colok) col = 0; }
    float acc[16];
#pragma unroll
    for (int r = 0; r < 16; ++r) acc[r] = 0.f;
#pragma unroll 1
    for (int k8 = 0; k8 < 4; ++k8) {
        float wv[8];
#pragma unroll
        for (int i = 0; i < 8; ++i) { const int k = ks * 32 + k8 * 8 + i; wv[i] = W[(size_t)k * ldw + col] * (MODE == 0 ? g[k] : 1.f); }
#pragma unroll
        for (int i = 0; i < 8; ++i) { const int k = ks * 32 + k8 * 8 + i;
#pragma unroll
            for (int q = 0; q < 4; ++q) { const f32x4 xv = *(LAS f32x4*)(xT + k * 16 + 4 * q);
                acc[4 * q] += wv[i] * xv[0]; acc[4 * q + 1] += wv[i] * xv[1]; acc[4 * q + 2] += wv[i] * xv[2]; acc[4 * q + 3] += wv[i] * xv[3]; } }
    }
#pragma unroll
    for (int r = 0; r < 16; ++r) red[(ks * 16 + r) * 16 + c] = colok ? acc[r] : 0.f;
    __syncthreads();
    if (F.tid < 256) {
        const int r = F.tid >> 4;
        float v = 0.f;
#pragma unroll 8
        for (int s_ = 0; s_ < 32; ++s_) v += red[(s_ * 16 + r) * 16 + c];
        if (MODE == 1) { F.hside[r * DM + n] += v; }
        else {
            v *= rr[r];
            if (item < 256) {
                const int pn = n >> 8;
                const int mode = (pn < 4) ? 1 : ((pn == 6 || pn == 7 || pn >= 14) ? 2 : 0);
                if (pn < 2 || pn == 8 || pn == 9) v *= C2;
                const float partner = __shfl_xor(v, 1);
                if (mode == 1) { const int j = (n & 63) >> 1; const float cs = F.rope[(r * 32 + j) * 2], sn = F.rope[(r * 32 + j) * 2 + 1];
                    v = (n & 1) ? (v * cs + partner * sn) : (v * cs - partner * sn); }
                else if (mode == 2) v = v * __builtin_amdgcn_rcpf(1.f + __builtin_amdgcn_exp2f(-v * LOG2E));
                const bf16 o = (bf16)f2bf(v);
                F.P[((size_t)48 + r) * NP + n] = o; F.P[((size_t)LP + 48 + r) * NP + n] = o;
                if (pn == 10 || pn == 11) {
                    float ss = v * v;
#pragma unroll
                    for (int o2 = 1; o2 < 16; o2 <<= 1) ss += __shfl_xor(ss, o2);
                    if (c == 0) atomicMax(F.ctl + 128 + layer * 128 + 32 + ((n - 2560) >> 4), __float_as_uint(ss));
                }
            } else if (c < 8) {
                const float xl = v + F.b_forget[layer * 8 + c];
                lfm[r * 8 + c] = fminf(xl, 0.f) - log1pf(expf(-fabsf(xl)));
            }
        }
    }
    __syncthreads();
    if (MODE == 0 && item == 256 && F.tid < 8) {
        float run = 0.f;
        for (int pp = 0; pp < 64; ++pp) { if (pp >= 48) run += lfm[(pp - 48) * 8 + F.tid];
            F.cumloc[(size_t)pp * 8 + F.tid] = run * LOG2E; F.cumloc[((size_t)LP + pp) * 8 + F.tid] = run * LOG2E; }
        F.cumtot[F.tid] = run * LOG2E; F.cumtot[TPB * 8 + F.tid] = run * LOG2E;
    }
    __syncthreads();
}

__device__ __forceinline__ void split3(float x, unsigned& h, unsigned& m, unsigned& l) {
    h = cvtpk(x, 0.f) & 0xffffu; const float r1 = x - __uint_as_float(h << 16);
    m = cvtpk(r1, 0.f) & 0xffffu; const float r2 = r1 - __uint_as_float(m << 16);
    l = cvtpk(r2, 0.f) & 0xffffu;
}
struct AttnP { const bf16* P; bf16* mixed; const float* cumloc; const float* cumtot; const float* subg; const unsigned* nrm; bf16* mixm; float lam; float one_m_li; };

template <bool DIFF>
__device__ __forceinline__ void attn_unit(const AttnP& A, int b, int h, int qi, ldsp lds) {
    constexpr int DV = DIFF ? 128 : 64, NTD = DV / 32, KP = DIFF ? 272 : 144, VP = DIFF ? 320 : 192, QROWS = DIFF ? 128 : 256, TPQ = QROWS / 64;
    constexpr int STAGE = 64 * KP + 64 * VP + 256, NPIECE = DIFF ? 2 : 1;
    int tid_ = threadIdx.x; asm volatile("" : "+v"(tid_));
    const int tid = tid_, lane = tid & 63, w = __builtin_amdgcn_readfirstlane(tid >> 6), r32 = lane & 31, hi = lane >> 5;
    const int comp = DIFF ? (w >> 2) : 0, wq = DIFF ? (w & 3) : w;
    const int qstart = qi == 0 ? 0 : 64 + QROWS * (qi - 1);
    const int nt = qi == 0 ? 1 : 1 + TPQ * qi;
    const int diag0 = qi == 0 ? 0 : nt - TPQ;
    const int q_pp = qstart + 32 * wq + r32, qmax_w = qstart + 32 * wq + 31;
    const bool store_ok = (qi != 0) || (b == 0 && q_pp >= 48 && q_pp < 64);
    const size_t Rb = (size_t)b * LP;
    const int qcol = DIFF ? h * 128 + comp * 64 : 2048 + h * 64;
    const int kcol = DIFF ? 512 + h * 128 : 2560 + h * 64;
    const int vcol = DIFF ? 1024 + h * 128 : 3072 + h * 64;
    const int zcol = DIFF ? 1536 + h * 128 : 3584 + h * 64;
    const int mcol = DIFF ? h * 128 : 512 + h * 64;
    const bf16* Pq = A.P + (Rb + q_pp) * NP;
    bf16x8 qf[4];
#pragma unroll
    for (int c = 0; c < 4; ++c) qf[c] = *(const bf16x8*)(Pq + qcol + 16 * c + 8 * hi);
    LAS float* pref = (LAS float*)(lds + LDS_PREF);
    u32x4 kreg[NPIECE], vreg[NPIECE]; float clreg = 0.f;
#define LOAD_TILE(kt) do { const bf16* base_ = A.P + (Rb + 64 * (size_t)(kt)) * NP; \
        _Pragma("unroll") for (int i_ = 0; i_ < NPIECE; ++i_) { const int p_ = tid + 512 * i_; const int row_ = DIFF ? (p_ >> 4) : (p_ >> 3); const int c16_ = DIFF ? (p_ & 15) : (p_ & 7); \
            kreg[i_] = *(const u32x4*)(base_ + (size_t)row_ * NP + kcol + c16_ * 8); vreg[i_] = *(const u32x4*)(base_ + (size_t)row_ * NP + vcol + c16_ * 8); } \
        if (!DIFF && tid < 64) clreg = A.cumloc[(Rb + 64 * (size_t)(kt) + tid) * 8 + h]; } while (0)
#define STORE_TILE(st) do { ldsp sb_ = lds + (st) * STAGE; \
        _Pragma("unroll") for (int i_ = 0; i_ < NPIECE; ++i_) { const int p_ = tid + 512 * i_; const int row_ = DIFF ? (p_ >> 4) : (p_ >> 3); const int c16_ = DIFF ? (p_ & 15) : (p_ & 7); \
            *(LAS u32x4*)(sb_ + row_ * KP + c16_ * 16) = kreg[i_]; *(LAS u32x4*)(sb_ + 64 * KP + row_ * VP + c16_ * 16) = vreg[i_]; } \
        if (!DIFF && tid < 64) { unsigned h_, m_, l_; split3(-clreg, h_, m_, l_); *(LAS u32x4*)(sb_ + tid * KP + 128) = (u32x4){h_ | (m_ << 16), l_ | 0x3f800000u, 0x3f803f80u, 0u}; } } while (0)
    int kt0 = 0;
    if (!DIFF) {
        LAS int* kst = (LAS int*)(lds + LDS_MISC + 64);
        if (tid == 0) *kst = nt - 1;
        if (w == 0) {
            float carry = 0.f;
#pragma unroll
            for (int ch = 0; ch < 3; ++ch) {
                const int idx = ch * 64 + lane;
                const float v = idx < TPB ? A.cumtot[(b * TPB + idx) * 8 + h] : 0.f;
                float inc = v;
#pragma unroll
                for (int o = 1; o < 64; o <<= 1) { const float t_ = __shfl_up(inc, o); if (lane >= o) inc += t_; }
                if (idx < TPB) pref[idx] = carry + inc - v;
                if (idx == TPB - 1) pref[TPB] = carry + inc;
                carry += __shfl(inc, 63);
            }
        }
        __syncthreads();
        const float q2 = __uint_as_float(A.nrm[(h) * 2]) + __uint_as_float(A.nrm[(h) * 2 + 1]), k2r = __uint_as_float(A.nrm[(8 + h) * 2]) + __uint_as_float(A.nrm[(8 + h) * 2 + 1]),
                    k2m = (__uint_as_float(A.nrm[32 + h * 4]) + __uint_as_float(A.nrm[32 + h * 4 + 1])) + (__uint_as_float(A.nrm[32 + h * 4 + 2]) + __uint_as_float(A.nrm[32 + h * 4 + 3])), k2 = fmaxf(k2r, k2m);
        const float thr = 2.0f * 1.03f * sqrtf(q2 * k2) + 40.0f;
        if (tid < nt) { if (pref[qstart >> 6] - pref[tid + 1] >= -thr) atomicMin((int*)kst, tid); }
        __syncthreads();
        kt0 = *kst;
    }
    LOAD_TILE(kt0);
    STORE_TILE(kt0 & 1);
    if (kt0 + 1 < nt) LOAD_TILE(kt0 + 1);
    asm volatile("s_waitcnt lgkmcnt(0)\n\ts_barrier" ::: "memory");
    float cq = 0.f;
    if (!DIFF) cq = pref[q_pp >> 6] + A.cumloc[(Rb + q_pp) * 8 + h];
    float mhat = 0.f, l_run = 0.f;
    f32x16 negm;
#pragma unroll
    for (int r = 0; r < 16; ++r) negm[r] = 0.f;
    f32x16 o[NTD];
#pragma unroll
    for (int t = 0; t < NTD; ++t)
#pragma unroll
        for (int r = 0; r < 16; ++r) o[t][r] = 0.f;
    const int trb = (4 * hi + ((lane & 15) >> 2)) * VP + ((lane >> 4) & 1) * 32 + (lane & 3) * 8;
    for (int kt = kt0; kt < nt; ++kt) {
        if (kt + 1 < nt) STORE_TILE((kt + 1) & 1);
        if (kt + 2 < nt) LOAD_TILE(kt + 2);
        if (64 * kt <= qmax_w) {
            ldsp Kb = lds + (kt & 1) * STAGE; ldsp Vb = Kb + 64 * KP;
            bf16x8 kf[8];
#pragma unroll
            for (int c = 0; c < 4; ++c) {
                kf[2 * c] = *(LAS bf16x8*)(Kb + r32 * KP + comp * 128 + c * 32 + hi * 16);
                kf[2 * c + 1] = *(LAS bf16x8*)(Kb + (32 + r32) * KP + comp * 128 + c * 32 + hi * 16);
            }
            __builtin_amdgcn_sched_barrier(0);
            f32x16 s0 = negm, s1 = negm;
            bf16x8 ka0, ka1, qa;
            if (!DIFF) {
                ka0 = *(LAS bf16x8*)(Kb + r32 * KP + 128); ka1 = *(LAS bf16x8*)(Kb + (32 + r32) * KP + 128);
                unsigned h_, m_, l_; split3(cq - pref[kt], h_, m_, l_);
                u32x4 qa_ = (u32x4){0x3f803f80u, 0x3f80u | (h_ << 16), m_ | (l_ << 16), 0u};
                if (hi) qa_ = (u32x4){0u, 0u, 0u, 0u};
                qa = __builtin_bit_cast(bf16x8, qa_);
            }
            __builtin_amdgcn_s_setprio(1);
            if (!DIFF) { s0 = __builtin_amdgcn_mfma_f32_32x32x16_bf16(ka0, qa, s0, 0, 0, 0); s1 = __builtin_amdgcn_mfma_f32_32x32x16_bf16(ka1, qa, s1, 0, 0, 0); }
#pragma unroll
            for (int c = 0; c < 4; ++c) {
                s0 = __builtin_amdgcn_mfma_f32_32x32x16_bf16(kf[2 * c], qf[c], s0, 0, 0, 0);
                s1 = __builtin_amdgcn_mfma_f32_32x32x16_bf16(kf[2 * c + 1], qf[c], s1, 0, 0, 0);
            }
            __builtin_amdgcn_s_setprio(0);
            s16x4 vlo[8], vhi[8];
#pragma unroll
            for (int t = 0; t < 2; ++t)
#pragma unroll
                for (int j = 0; j < 4; ++j) { vlo[t * 4 + j] = vtr(Vb + trb + (16 * j) * VP + t * 64); vhi[t * 4 + j] = vtr(Vb + trb + (16 * j + 8) * VP + t * 64); }
            __builtin_amdgcn_sched_barrier(0);
            if (kt == 0 || kt >= diag0) {
#pragma unroll
                for (int r = 0; r < 16; ++r) { const int kpp = 64 * kt + crow(r, hi);
                    if (kpp < 48 || kpp > q_pp) s0[r] = -INFINITY;
                    if (kpp + 32 < 48 || kpp + 32 > q_pp) s1[r] = -INFINITY; }
            }
            float ma = fmaxf(fmaxf(s0[0], s0[1]), s1[0]), mb = fmaxf(fmaxf(s0[2], s0[3]), s1[1]);
            ma = fmaxf(fmaxf(ma, s1[2]), s1[3]);
#pragma unroll
            for (int r = 4; r < 16; r += 4) { ma = fmaxf(fmaxf(ma, s0[r]), s0[r + 1]); mb = fmaxf(fmaxf(mb, s0[r + 2]), s0[r + 3]); ma = fmaxf(fmaxf(ma, s1[r]), s1[r + 1]); mb = fmaxf(fmaxf(mb, s1[r + 2]), s1[r + 3]); }
            const float rm = swap32_max(fmaxf(ma, mb));
            if (kt == kt0 || __any(rm > 8.0f)) {
                const float dl = (kt == kt0) ? ((rm == -INFINITY) ? 0.f : rm) : fmaxf(rm, 0.f);
                mhat += dl;
#pragma unroll
                for (int r = 0; r < 16; ++r) { s0[r] -= dl; s1[r] -= dl; negm[r] = -mhat; }
                const float f = (kt == kt0) ? 1.0f : __builtin_amdgcn_exp2f(-dl);
                l_run *= f;
#pragma unroll
                for (int t = 0; t < NTD; ++t)
#pragma unroll
                    for (int r = 0; r < 16; ++r) o[t][r] *= f;
            }
            float psa = 0.f, psb = 0.f;
#pragma unroll
            for (int r = 0; r < 16; ++r) { s0[r] = __builtin_amdgcn_exp2f(s0[r]); s1[r] = __builtin_amdgcn_exp2f(s1[r]); psa += s0[r]; asm("" : "+v"(psa)); psb += s1[r]; asm("" : "+v"(psb)); }
            l_run += psa + psb;
            bf16x8 pw[4];
#pragma unroll
            for (int j = 0; j < 4; ++j) {
                u32x4 pk;
                if (j < 2) { const int rb = 8 * (j & 1); pk.x = cvtpk(s0[rb], s0[rb + 1]); pk.y = cvtpk(s0[rb + 2], s0[rb + 3]); pk.z = cvtpk(s0[rb + 4], s0[rb + 5]); pk.w = cvtpk(s0[rb + 6], s0[rb + 7]); }
                else { const int rb = 8 * (j & 1); pk.x = cvtpk(s1[rb], s1[rb + 1]); pk.y = cvtpk(s1[rb + 2], s1[rb + 3]); pk.z = cvtpk(s1[rb + 4], s1[rb + 5]); pk.w = cvtpk(s1[rb + 6], s1[rb + 7]); }
                pw[j] = __builtin_bit_cast(bf16x8, pk);
            }
            __builtin_amdgcn_sched_barrier(0);
            __builtin_amdgcn_s_setprio(1);
#pragma unroll
            for (int t = 0; t < 2; ++t)
#pragma unroll
                for (int j = 0; j < 4; ++j) {
                    const bf16x8 vf = (bf16x8){vlo[t * 4 + j][0], vlo[t * 4 + j][1], vlo[t * 4 + j][2], vlo[t * 4 + j][3], vhi[t * 4 + j][0], vhi[t * 4 + j][1], vhi[t * 4 + j][2], vhi[t * 4 + j][3]};
                    o[t] = __builtin_amdgcn_mfma_f32_32x32x16_bf16(vf, pw[j], o[t], 0, 0, 0);
                }
            if (DIFF) {
#pragma unroll
                for (int t = 2; t < NTD; ++t)
#pragma unroll
                    for (int j = 0; j < 4; ++j) { vlo[(t - 2) * 4 + j] = vtr(Vb + trb + (16 * j) * VP + t * 64); vhi[(t - 2) * 4 + j] = vtr(Vb + trb + (16 * j + 8) * VP + t * 64); }
                __builtin_amdgcn_sched_barrier(0);
#pragma unroll
                for (int t = 2; t < NTD; ++t)
#pragma unroll
                    for (int j = 0; j < 4; ++j) {
                        const int i = (t - 2) * 4 + j;
                        const bf16x8 vf = (bf16x8){vlo[i][0], vlo[i][1], vlo[i][2], vlo[i][3], vhi[i][0], vhi[i][1], vhi[i][2], vhi[i][3]};
                        o[t] = __builtin_amdgcn_mfma_f32_32x32x16_bf16(vf, pw[j], o[t], 0, 0, 0);
                    }
            }
            __builtin_amdgcn_s_setprio(0);
        }
        asm volatile("s_waitcnt lgkmcnt(0)\n\ts_barrier" ::: "memory");
    }
#undef LOAD_TILE
#undef STORE_TILE
    const float lt = swap32_sum(l_run);
    const float inv = lt > 0.f ? 1.0f / lt : 0.f;
    const size_t Rq = Rb + q_pp;
    bf16* mrow = (qi != 0) ? A.mixed + ((size_t)b * T + (q_pp - 64)) * DM : A.mixm + (size_t)((q_pp - 48) & 15) * DM;
    if (!DIFF) {
        if (store_ok) {
#pragma unroll
            for (int t = 0; t < NTD; ++t)
#pragma unroll
                for (int g = 0; g < 4; ++g) {
                    const int dv0 = 32 * t + 8 * g + 4 * hi;
                    const u32x2 z = *(const u32x2*)(A.P + Rq * NP + zcol + dv0);
                    u32x2 wv; wv.x = cvtpk(o[t][4 * g] * inv * bf_lo(z.x), o[t][4 * g + 1] * inv * bf_hi(z.x)); wv.y = cvtpk(o[t][4 * g + 2] * inv * bf_lo(z.y), o[t][4 * g + 3] * inv * bf_hi(z.y));
                    *(u32x2*)(mrow + mcol + dv0) = wv;
                }
        }
    } else {
        LAS float* xch = (LAS float*)lds;
        if (comp == 1) {
            const float f = inv * A.lam;
#pragma unroll
            for (int t = 0; t < NTD; ++t)
#pragma unroll
                for (int r = 0; r < 16; ++r) xch[(t * 16 + r) * 256 + wq * 64 + lane] = o[t][r] * f;
        }
        __syncthreads();
        if (comp == 0) {
            float ss = 0.f;
#pragma unroll
            for (int t = 0; t < NTD; ++t)
#pragma unroll
                for (int r = 0; r < 16; ++r) { const float v = o[t][r] * inv - xch[(t * 16 + r) * 256 + wq * 64 + lane]; o[t][r] = v; ss += v * v; }
            ss = swap32_sum(ss);
            const float rn = rsqrtf(ss * (1.0f / 128.0f) + NORM_EPS) * A.one_m_li;
            if (store_ok) {
#pragma unroll
                for (int t = 0; t < NTD; ++t)
#pragma unroll
                    for (int g = 0; g < 4; ++g) {
                        const int dv0 = 32 * t + 8 * g + 4 * hi;
                        const u32x2 z = *(const u32x2*)(A.P + Rq * NP + zcol + dv0);
                        const f32x4 sg = *(const f32x4*)(A.subg + h * 128 + dv0);
                        u32x2 wv; wv.x = cvtpk(o[t][4 * g] * rn * sg[0] * bf_lo(z.x), o[t][4 * g + 1] * rn * sg[1] * bf_hi(z.x));
                        wv.y = cvtpk(o[t][4 * g + 2] * rn * sg[2] * bf_lo(z.y), o[t][4 * g + 3] * rn * sg[3] * bf_hi(z.y));
                        *(u32x2*)(mrow + mcol + dv0) = wv;
                    }
            }
        }
        __syncthreads();
    }
}

__device__ __forceinline__ void attn_phase(Frame& F, int layer, int rep) {
    AttnP A; A.P = F.P; A.mixed = F.mix; A.cumloc = F.cumloc; A.cumtot = F.cumtot; A.subg = F.subln_g + layer * 512; A.nrm = F.ctl + 128 + layer * 128; A.mixm = F.mixm;
    A.lam = F.lam[layer]; A.one_m_li = 1.0f - (0.8f - 0.6f * expf(-0.3f * (float)layer));
    LAS int* cur = (LAS int*)(F.lds + LDS_MISC);
    unsigned* counter = F.ctl + 16 * (layer + 1) + 4 * rep;
    for (;;) {
        if (F.tid == 0) *cur = (int)atomicAdd(counter, 1u);
        __syncthreads();
        const int idx = *cur;
        __syncthreads();
        if (idx >= N_UNITS) break;
        const int u = F.units[layer * N_UNITS + idx];
        if (u < N_DIFF_UNITS) {
#ifndef NO_DIFF
            const int bh = u / 65, qi = u % 65; attn_unit<true>(A, bh >> 2, bh & 3, qi, F.lds);
#endif
        }
#ifndef NO_FOX
        else { const int v = u - N_DIFF_UNITS; const int bh = v / 33, qi = v % 33; attn_unit<false>(A, bh >> 3, bh & 7, qi, F.lds); }
#endif
    }
}

__device__ __forceinline__ void final_phase(Frame& F) {
    const int gw = F.bid * 8 + F.wave, NGW = F.G * 8;
    for (int m = gw; m < NB * T; m += NGW) {
        const float rs = rsqrtf(F.sumsq[2 * MG + m] * (1.0f / DM) + NORM_EPS);
        float* p = F.out + (size_t)m * DM;
#pragma unroll
        for (int j = 0; j < 4; ++j) { const f32x4 v = *(const f32x4*)(p + 4 * F.lane + 256 * j); const f32x4 g = *(const f32x4*)(F.final_g + 4 * F.lane + 256 * j); *(f32x4*)(p + 4 * F.lane + 256 * j) = v * rs * g; }
    }
}

#define XB_TMO      128
#define XB_XCNT(j)  (256  + 64 * (j))
#define XB_XSUB(j)  (1280 + 64 * (j))
#define XB_XGEN(j)  (2304 + 64 * (j))
#define XB_TOP      3328
#define XB_TOPGEN   3392
#define XCD_BAR_WORDS 3456
#define XB_SPIN_CAP (1u << 18)

__device__ __forceinline__ unsigned xb_ld(unsigned* p)              { return __hip_atomic_load(p, __ATOMIC_RELAXED, __HIP_MEMORY_SCOPE_AGENT); }
__device__ __forceinline__ unsigned xb_add(unsigned* p, unsigned v) { return __hip_atomic_fetch_add(p, v, __ATOMIC_RELAXED, __HIP_MEMORY_SCOPE_AGENT); }
__device__ __forceinline__ unsigned xb_xcc_id() { return (unsigned)__builtin_amdgcn_s_getreg((3 << 11) | 20) & 0xFu; }
#define XB_SPIN(cond, bar) do { unsigned _sp = 0; while (cond) { __builtin_amdgcn_s_sleep(1); \
    if ((++_sp & 255u) == 0u) { if (xb_ld(&(bar)[XB_TMO])) break; if (_sp > XB_SPIN_CAP) { atomicAdd(&(bar)[XB_TMO], 1u); break; } } } } while (0)

struct XcdBarrier {
    unsigned* bar; unsigned x;
    volatile LAS unsigned* st;
};

__device__ __forceinline__ XcdBarrier xcd_barrier_post(unsigned* bar, volatile LAS unsigned* st) {
    XcdBarrier b; b.bar = bar; b.x = xb_xcc_id(); b.st = st;
    if (threadIdx.x == 0) (void)xb_add(&bar[XB_XCNT(b.x)], 1u);
    return b;
}
__device__ __forceinline__ void xcd_barrier_complete(unsigned* bar, unsigned x, unsigned& nloc, unsigned& nx) {
    const unsigned G = gridDim.x * gridDim.y * gridDim.z;
    unsigned sum, cnt, mine, sp = 0u;
    for (;;) {
        sum = 0u; cnt = 0u; mine = 0u;
#pragma unroll
        for (unsigned j = 0; j < 16; ++j) { const unsigned c = xb_ld(&bar[XB_XCNT(j)]); sum += c; cnt += (c > 0u) ? 1u : 0u; mine = (j == x) ? c : mine; }
        if (sum == G) break;
        __builtin_amdgcn_s_sleep(1);
        if ((++sp & 255u) == 0u) { if (xb_ld(&bar[XB_TMO])) break; if (sp > XB_SPIN_CAP) { atomicAdd(&bar[XB_TMO], 1u); break; } }
    }
    nloc = mine > 0u ? mine : 1u; nx = cnt > 0u ? cnt : 1u;
}

__device__ __forceinline__ void xcd_barrier(const XcdBarrier& b) {
    asm volatile("s_waitcnt vmcnt(0)" ::: "memory");
    __syncthreads();
    if (threadIdx.x == 0) {
        unsigned* bar = b.bar;
        __builtin_amdgcn_s_waitcnt(0);
        unsigned nloc = b.st[0], nx = b.st[1];
        if (nloc == 0u) { xcd_barrier_complete(bar, b.x, nloc, nx); b.st[0] = nloc; b.st[1] = nx; }
        const unsigned old = xb_add(&bar[XB_XSUB(b.x)], 1u);
        const unsigned gen = old / nloc;
        if (old + 1u == (gen + 1u) * nloc) {
            __builtin_amdgcn_fence(__ATOMIC_RELEASE, "agent");
            asm volatile("s_waitcnt vmcnt(0)" ::: "memory");
            const unsigned og = xb_add(&bar[XB_TOP], 1u);
            const unsigned tg = og / nx;
            if (og + 1u == (tg + 1u) * nx) xb_add(&bar[XB_TOPGEN], 1u);
            else XB_SPIN(xb_ld(&bar[XB_TOPGEN]) == tg, bar);
            __builtin_amdgcn_fence(__ATOMIC_ACQUIRE, "agent");
            xb_add(&bar[XB_XGEN(b.x)], 1u);
            asm volatile("s_waitcnt vmcnt(0)" ::: "memory");
        } else {
            XB_SPIN(xb_ld(&bar[XB_XGEN(b.x)]) == gen, bar);
            __builtin_amdgcn_fence(__ATOMIC_ACQUIRE, "agent");
            asm volatile("s_waitcnt vmcnt(0)" ::: "memory");
        }
    }
    __syncthreads();
}

struct Args { const float* in[12]; float* out; unsigned char* ws; int ph_lo, ph_hi; };
typedef const __attribute__((address_space(4))) Args* kargp;
__device__ __forceinline__ void make_frame(Frame& F, ldsp lds) {
    kargp ap = (kargp)__builtin_amdgcn_kernarg_segment_ptr();
    asm volatile("" : "+s"(ap));
    int tid = threadIdx.x; asm volatile("" : "+v"(tid));
    F.lds = lds; F.tid = tid; F.lane = tid & 63; F.wave = __builtin_amdgcn_readfirstlane(tid >> 6); F.G = gridDim.x; F.bid = blockIdx.x;
    F.x = ap->in[0]; F.meta = ap->in[1]; F.norm_g = ap->in[2]; F.w_in = ap->in[3]; F.b_forget = ap->in[4]; F.lq1 = ap->in[5]; F.lk1 = ap->in[6]; F.lq2 = ap->in[7]; F.lk2 = ap->in[8];
    F.subln_g = ap->in[9]; F.w_out = ap->in[10]; F.final_g = ap->in[11]; F.out = ap->out; F.ws = ap->ws;
    unsigned char* ws = ap->ws;
    F.ctl = (unsigned*)(ws + WS_CTL); F.lam = (float*)(ws + WS_LAM); F.units = (int*)(ws + WS_UNITS); F.sumsq = (float*)(ws + WS_SUMSQ); F.cumtot = (float*)(ws + WS_CUMTOT); F.cumloc = (float*)(ws + WS_CUMLOC);
    F.hside = (float*)(ws + WS_HSIDE); F.rope = (float*)(ws + WS_ROPE); F.win_t = (bf16*)(ws + WS_WIN); F.wout_t = (bf16*)(ws + WS_WOUT); F.hb = (bf16*)(ws + WS_HB); F.mix = (bf16*)(ws + WS_MIX); F.P = (bf16*)(ws + WS_P); F.mixm = (bf16*)(ws + WS_HSIDE + 128 * 1024);
}
__global__ void __launch_bounds__(512) hymba_fwd(Args args) {
    extern __shared__ __attribute__((aligned(16))) unsigned char lds_raw[];
    const ldsp lds = (ldsp)lds_raw;
    const int lo = args.ph_lo, hi = args.ph_hi;
    const bool fuse_final = (lo == 0 && hi == 8 && gridDim.x == 256);
    volatile LAS unsigned* bst = (volatile LAS unsigned*)(lds + LDS_MISC + 128);
    if (threadIdx.x < 2) bst[threadIdx.x] = 0u;
    __syncthreads();
    XcdBarrier xbar; xbar.bar = (unsigned*)(args.ws + WS_BAR); xbar.x = 0; xbar.st = bst;
    if (hi - lo > 1) xbar = xcd_barrier_post((unsigned*)(args.ws + WS_BAR), bst);
    if (lo < 0) cg::this_grid().sync();
#define IN(k) (lo <= (k) && (k) < hi)
#define SEAM(k) do { if (IN(k) && IN((k) + 1)) { xcd_barrier(xbar); } } while (0)
#ifndef REP_PRO
#define REP_PRO 1
#endif
#ifndef REP_IN
#define REP_IN 1
#endif
#ifndef REP_ATTN
#define REP_ATTN 1
#endif
    if (IN(0)) { for (int rep = 0; rep < REP_PRO; ++rep) { Frame F; make_frame(F, lds); p0_prologue(F); if (rep + 1 < REP_PRO) xcd_barrier(xbar); } }
    SEAM(0);
#pragma unroll 1
    for (int layer = 0; layer < 2; ++layer) {
        const int pb = 1 + 3 * layer;
        if (IN(pb)) { for (int rep = 0; rep < REP_IN; ++rep) {
#ifndef NO_FORGET
            { Frame F; make_frame(F, lds); for (int tile = F.bid; tile < MG / 64; tile += F.G) forget_item(F, layer, tile);
              for (int it = F.G - 1 - F.bid; it < 257; it += F.G) meta_item<0>(F, layer, it); }
#endif
#ifndef NO_GIN
            { Frame F; make_frame(F, lds);
              pg8::Gemm g{F.hb, F.win_t + (size_t)layer * NP * DM, MG, NP, DM}; pg8::StaticOrder S; S.init(MG, NP, F.G, F.bid);
              pg8::EpiIn E{F.P, F.sumsq + layer * MG, F.rope, F.ctl + 128 + layer * 128};
              pg8::gemm_phase<pg8::EpiIn, pg8::StaticOrder, true, true>(F.lds, g, S, E); }
#endif
        } }
        SEAM(pb);
        if (IN(pb + 1)) { for (int rep = 0; rep < REP_ATTN; ++rep) { Frame F; make_frame(F, lds); attn_phase(F, layer, rep); } }
        SEAM(pb + 1);
        if (IN(pb + 2)) {
#ifndef NO_GOUT
            Frame F; make_frame(F, lds);
            if (layer == 0) { for (int it = F.bid; it < DM / 16; it += F.G) meta_item<1>(F, layer, it); }
            pg8::Gemm g{F.mix, F.wout_t + (size_t)layer * DM * DM, MG, DM, DM}; pg8::StaticOrder S; S.init(MG, DM, F.G, F.bid);
            if (layer == 1 && fuse_final) {
                pg8::EpiOutFinal E{(const float*)F.out, F.out, F.sumsq + 2 * MG, F.ctl + 448, F.final_g};
                pg8::gemm_phase<pg8::EpiOutFinal, pg8::StaticOrder, true, true>(F.lds, g, S, E);
            } else {
                pg8::EpiOut E{layer == 0 ? F.x : (const float*)F.out, F.out, F.hb, F.sumsq + (layer + 1) * MG, layer == 0 ? 1 : 0};
                pg8::gemm_phase<pg8::EpiOut, pg8::StaticOrder, true, true>(F.lds, g, S, E);
            }
#endif
        }
        if (!(layer == 1 && fuse_final)) SEAM(pb + 2);
    }
    if (IN(7) && !fuse_final) { Frame F; make_frame(F, lds); final_phase(F); }
#undef IN
#undef SEAM
}

extern "C" void kernel_launch(void* const* d_in, const int* in_sizes, int n_in, void* d_out, int out_size, void* d_ws, size_t ws_size, hipStream_t stream) {
    static int grid = 0;
    if (grid == 0) {
        if (n_in != 12 || out_size != NB * T * DM || ws_size < WS_END) { fprintf(stderr, "kernel_launch: unexpected shapes (n_in %d out %d ws %zu)\n", n_in, out_size, ws_size); grid = -1; return; }
        int dev = 0, cus = 0, per_cu = 0;
        (void)hipGetDevice(&dev); (void)hipDeviceGetAttribute(&cus, hipDeviceAttributeMultiprocessorCount, dev);
        if (hipFuncSetAttribute((const void*)hymba_fwd, hipFuncAttributeMaxDynamicSharedMemorySize, LDS_BYTES) != hipSuccess) { fprintf(stderr, "kernel_launch: hipFuncSetAttribute failed\n"); grid = -1; return; }
        if (hipOccupancyMaxActiveBlocksPerMultiprocessor(&per_cu, (const void*)hymba_fwd, 512, LDS_BYTES) != hipSuccess || per_cu < 1) per_cu = 1;
        (void)hipGetLastError();
        grid = cus * per_cu;
        if (grid <= 0) grid = 256;
    }
    if (grid < 0) return;
    Args a{};
    for (int i = 0; i < 12; ++i) a.in[i] = (const float*)d_in[i];
    a.out = (float*)d_out; a.ws = (unsigned char*)d_ws;
#if MK_SINGLE
    (void)hipMemsetAsync((unsigned char*)d_ws + WS_BAR, 0, 16384, stream);
    a.ph_lo = 0; a.ph_hi = 8;
    void* kargs[] = {&a};
    hipError_t e = hipLaunchCooperativeKernel((const void*)hymba_fwd, dim3(grid), dim3(512), kargs, LDS_BYTES, stream);
    if (e != hipSuccess) fprintf(stderr, "cooperative launch failed: %s (grid %d)\n", hipGetErrorString(e), grid);
#else
    for (int p = 0; p < 8; ++p) {
        a.ph_lo = p; a.ph_hi = p + 1;
        hipLaunchKernelGGL(hymba_fwd, dim3(grid), dim3(512), LDS_BYTES, stream, a);
    }
#endif
}
```

```cpp
#include <hip/hip_runtime.h>
#include <hip/hip_cooperative_groups.h>
#include <cstdio>
#include <cstdint>
#include <cmath>
namespace cg = cooperative_groups;

#ifndef MK_SINGLE
#define MK_SINGLE 1
#endif

constexpr int MG = 16384;
constexpr int NB = 2, T = 8192, NMETA = 16, LP = 8256, MV = 2 * LP  , MR = 16640, DM = 1024, NP = 4096, PW = 4104, TPB = LP / 64  , NT64 = MV / 64  ;
constexpr float LOG2E = 1.4426950408889634f;
constexpr float C2 = 0.125f * LOG2E;
constexpr float NORM_EPS = 1e-6f;

__device__ __forceinline__ bool row_valid(int R) { if (R >= MV) return false; const int pp = R >= LP ? R - LP : R; return pp >= 48; }
__device__ __forceinline__ int row_pos(int R) { const int pp = R >= LP ? R - LP : R; return pp - 48; }
__device__ __forceinline__ float* hrow(float* out, float* hside, int R) {
    if (R >= MV) return hside + (size_t)(128 + R - MV) * DM;
    const int b = R >= LP ? 1 : 0, pp = R - b * LP;
    if (pp < 64) return hside + (size_t)(b * 64 + pp) * DM;
    return out + ((size_t)b * T + (pp - 64)) * DM;
}

namespace pg8 {
#define PG8_LAS __attribute__((address_space(3)))
typedef unsigned short bf16_t;
typedef short bf16x8 __attribute__((ext_vector_type(8)));
typedef float f32x4 __attribute__((ext_vector_type(4)));
typedef unsigned u32x4 __attribute__((ext_vector_type(4)));
constexpr int BM = 256, BK = 64, HALF = 128, HTB = HALF * BK * 2  , STAGE_BYTES = 8 * HTB, NXCD = 8, WGM = 8;

__host__ __device__ __forceinline__ int lds_byte(int r, int c) { const int st = (r >> 4) * 2 + (c >> 5), rr = r & 15, cc = c & 31, ob = rr * 64 + cc * 2; return st * 1024 + (ob ^ (((ob >> 9) & 1) << 5)); }
__host__ __device__ __forceinline__ void stage_rc(int b, int& R, int& C) { const int st = b / 1024, sb = b % 1024, swz = sb ^ (((sb >> 9) & 1) << 5); R = (st >> 1) * 16 + swz / 64; C = (st & 1) * 32 + (swz % 64) / 2; }
__host__ __device__ __forceinline__ int perm32(int rho) { const int n = rho >> 4, i = rho & 15; return 8 * (i >> 2) + 4 * n + (i & 3); }

struct Unit { int pm, pn; };
struct Gemm { const bf16_t* A; const bf16_t* Bt; int M, N, K; };

struct StaticOrder {
    int nM, nN, nwg, G, c;
    __host__ __device__ void init(int M, int N, int G_, int c_) { nM = M / BM; nN = N / BM; nwg = nM * nN; G = G_; c = c_; }
    __host__ __device__ bool next(int i, Unit& u) const {
        const long L = (long)i * G + c; if (L >= nwg) return false;
        int wgid = (int)L; { const int q = nwg / NXCD, r = nwg % NXCD, xcd = wgid % NXCD, off = wgid / NXCD; wgid = (xcd < r ? xcd * (q + 1) : r * (q + 1) + (xcd - r) * q) + off; }
        const int nig = WGM * nN, gid = wgid / nig, fm = gid * WGM, gsz = (nM - fm) < WGM ? (nM - fm) : WGM;
        u.pm = fm + ((wgid % nig) % gsz); u.pn = (wgid % nig) / gsz; return true;
    }
    __device__ __forceinline__ void a_ready(const Unit&) const {}
    __device__ __forceinline__ void done(const Unit&) const {}
};


__device__ __forceinline__ unsigned cvt_pk_bf16(float lo, float hi) { unsigned r; asm volatile("v_cvt_pk_bf16_f32 %0, %1, %2" : "=v"(r) : "v"(lo), "v"(hi)); return r; }
typedef unsigned u32x2 __attribute__((ext_vector_type(2)));
struct EpiIn {
    static constexpr bool PERM = true, AFTER_DRAIN = false;
    bf16_t* P; const float* sumsq; const float* rope; unsigned* nrm;
    __device__ __forceinline__ void operator()(const f32x4 (&acc)[2][2][4][2], const Unit& u, int wr, int wc, int fr, int fq) const {
        const int pn = u.pn;
        const int mode = (pn < 4) ? 1 : ((pn == 6 || pn == 7 || pn >= 14) ? 2 : 0);
        const float sc = (pn < 2 || pn == 8 || pn == 9) ? C2 : 1.f;
        const int colb = pn * 256 + wc * 32 + 8 * fq;
        float mxb[2] = {0.f, 0.f};
#pragma unroll
        for (int ai = 0; ai < 2; ++ai)
#pragma unroll
            for (int m = 0; m < 4; ++m) {
                const int row = u.pm * BM + ai * HALF + wr * 64 + m * 16 + fr;
                const float rs = rsqrtf(sumsq[row] * (1.0f / DM) + NORM_EPS) * sc;
                const int bb = row >> 13, tt = row & 8191; const size_t R = (size_t)bb * LP + 64 + tt; const int pos = 16 + tt;
#pragma unroll
                for (int bj = 0; bj < 2; ++bj) {
                    const int col = colb + bj * HALF;
                    f32x4 v0 = acc[ai][bj][m][0] * rs, v1 = acc[ai][bj][m][1] * rs;
                    if (mode == 1) {
                        const int j0 = (col & 63) >> 1;
                        const f32x4* cs = (const f32x4*)(rope + ((size_t)pos * 32 + j0) * 2);
                        const f32x4 a = cs[0], b = cs[1];
                        f32x4 w0, w1;
                        w0[0] = v0[0] * a[0] - v0[1] * a[1]; w0[1] = v0[1] * a[0] + v0[0] * a[1];
                        w0[2] = v0[2] * a[2] - v0[3] * a[3]; w0[3] = v0[3] * a[2] + v0[2] * a[3];
                        w1[0] = v1[0] * b[0] - v1[1] * b[1]; w1[1] = v1[1] * b[0] + v1[0] * b[1];
                        w1[2] = v1[2] * b[2] - v1[3] * b[3]; w1[3] = v1[3] * b[2] + v1[2] * b[3];
                        v0 = w0; v1 = w1;
                    } else if (mode == 2) {
#pragma unroll
                        for (int i = 0; i < 4; ++i) { v0[i] = v0[i] * __builtin_amdgcn_rcpf(1.f + __builtin_amdgcn_exp2f(-v0[i] * LOG2E)); v1[i] = v1[i] * __builtin_amdgcn_rcpf(1.f + __builtin_amdgcn_exp2f(-v1[i] * LOG2E)); }
                    }
                    u32x4 w; w.x = cvt_pk_bf16(v0[0], v0[1]); w.y = cvt_pk_bf16(v0[2], v0[3]); w.z = cvt_pk_bf16(v1[0], v1[1]); w.w = cvt_pk_bf16(v1[2], v1[3]);
                    *(u32x4*)(P + R * NP + col) = w;
                    if (pn >= 8 && pn < 12) { float ss = (v0[0] * v0[0] + v0[1] * v0[1]) + (v0[2] * v0[2] + v0[3] * v0[3]) + (v1[0] * v1[0] + v1[1] * v1[1]) + (v1[2] * v1[2] + v1[3] * v1[3]);
                        ss += __shfl_xor(ss, 16); ss += __shfl_xor(ss, 32); mxb[bj] = fmaxf(mxb[bj], ss); }
                }
            }
        if (pn >= 8 && pn < 12) {
#pragma unroll
            for (int bj = 0; bj < 2; ++bj) { float mx = mxb[bj];
#pragma unroll
                for (int o = 1; o < 16; o <<= 1) mx = fmaxf(mx, __shfl_xor(mx, o));
                if (fr == 0 && fq == 0) atomicMax(nrm + (((pn >= 10) ? 8 : 0) + (pn & 1) * 4 + bj * 2 + (wc >> 1)) * 2 + (wc & 1), __float_as_uint(mx)); }
        }
    }
};
struct EpiOut {
    static constexpr bool PERM = false, AFTER_DRAIN = false;
    const float* base; float* out; bf16_t* hb; float* sumsq_next; int write_hb;
    __device__ __forceinline__ void operator()(const f32x4 (&acc)[2][2][4][2], const Unit& u, int wr, int wc, int fr, int fq) const {
        const int col0 = u.pn * BM + wc * 32 + 4 * fq;
#pragma unroll
        for (int ai = 0; ai < 2; ++ai)
#pragma unroll
            for (int m = 0; m < 4; ++m) {
                const int row = u.pm * BM + ai * HALF + wr * 64 + m * 16 + fr;
                float* hp = out + (size_t)row * DM; const float* bp = base + (size_t)row * DM;
                float ss = 0.f;
#pragma unroll
                for (int bj = 0; bj < 2; ++bj)
#pragma unroll
                    for (int n = 0; n < 2; ++n) {
                        const int c = col0 + bj * HALF + n * 16;
                        const f32x4 hv = *(const f32x4*)(bp + c);
                        f32x4 o = hv + acc[ai][bj][m][n];
                        *(f32x4*)(hp + c) = o;
                        ss += (o[0] * o[0] + o[1] * o[1]) + (o[2] * o[2] + o[3] * o[3]);
                        if (write_hb) { u32x2 w; w.x = cvt_pk_bf16(o[0], o[1]); w.y = cvt_pk_bf16(o[2], o[3]); *(u32x2*)(hb + (size_t)row * DM + c) = w; }
                    }
                ss += __shfl_xor(ss, 16); ss += __shfl_xor(ss, 32);
                if (fq == 0) atomicAdd(sumsq_next + row, ss);
            }
    }
};
struct EpiOutFinal {
    static constexpr bool PERM = false, AFTER_DRAIN = false;
    const float* base; float* out; float* sumsq; unsigned* cnt; const float* fg;
    __device__ __forceinline__ void operator()(f32x4 (&acc)[2][2][4][2], const Unit& u, int wr, int wc, int fr, int fq) const {
        const int col0 = u.pn * BM + wc * 32 + 4 * fq;
#pragma unroll
        for (int ai = 0; ai < 2; ++ai)
#pragma unroll
            for (int m = 0; m < 4; ++m) {
                const int row = u.pm * BM + ai * HALF + wr * 64 + m * 16 + fr;
                const float* bp = base + (size_t)row * DM;
                float ss = 0.f;
#pragma unroll
                for (int bj = 0; bj < 2; ++bj)
#pragma unroll
                    for (int n = 0; n < 2; ++n) {
                        const f32x4 o = *(const f32x4*)(bp + col0 + bj * HALF + n * 16) + acc[ai][bj][m][n];
                        acc[ai][bj][m][n] = o;
                        ss += (o[0] * o[0] + o[1] * o[1]) + (o[2] * o[2] + o[3] * o[3]);
                    }
                ss += __shfl_xor(ss, 16); ss += __shfl_xor(ss, 32);
                if (fq == 0) atomicAdd(sumsq + row, ss);
            }
        asm volatile("s_waitcnt vmcnt(0)" ::: "memory");
        __syncthreads();
        if (threadIdx.x == 0) {
            __hip_atomic_fetch_add(cnt + u.pm, 1u, __ATOMIC_RELAXED, __HIP_MEMORY_SCOPE_AGENT);
            unsigned spins = 0;
            while (__hip_atomic_load(cnt + u.pm, __ATOMIC_RELAXED, __HIP_MEMORY_SCOPE_AGENT) < 4u && ++spins < (1u << 22)) __builtin_amdgcn_s_sleep(1);
        }
        __syncthreads();
#pragma unroll
        for (int ai = 0; ai < 2; ++ai)
#pragma unroll
            for (int m = 0; m < 4; ++m) {
                const int row = u.pm * BM + ai * HALF + wr * 64 + m * 16 + fr;
                const float ssr = __hip_atomic_load(sumsq + row, __ATOMIC_RELAXED, __HIP_MEMORY_SCOPE_AGENT);
                const float r = rsqrtf(ssr * (1.0f / DM) + NORM_EPS);
#pragma unroll
                for (int bj = 0; bj < 2; ++bj)
#pragma unroll
                    for (int n = 0; n < 2; ++n) {
                        const int c = col0 + bj * HALF + n * 16;
                        const f32x4 g = *(const f32x4*)(fg + c);
                        *(f32x4*)(out + (size_t)row * DM + c) = acc[ai][bj][m][n] * r * g;
                    }
            }
    }
};

template <class Epi, class Sched, bool ALIGN_EPI = false, bool SP2 = false>
__device__ __forceinline__ void gemm_phase(PG8_LAS unsigned char* lds, const Gemm g, const Sched& S, const Epi& E) {
    int tid_ = threadIdx.x; asm volatile("" : "+v"(tid_));
    const int tid = tid_, wid = __builtin_amdgcn_readfirstlane(tid >> 6), lane = tid & 63, wr = wid >> 2, wc = wid & 3, fr = lane & 15, fq = lane >> 4;
    const int K = g.K, nt = K / BK;
    unsigned voffA[2], voffB[2];
#pragma unroll
    for (int i = 0; i < 2; ++i) { int R, C; stage_rc(tid * 16 + i * 8192, R, C); const int Rb = Epi::PERM ? ((R & ~31) + perm32(R & 31)) : R;
        voffA[i] = (unsigned)(R * K + C) * 2u; voffB[i] = (unsigned)(Rb * K + C) * 2u; }
    const size_t kstep = (size_t)(BK * 2);
    const size_t hstep = (size_t)HALF * K * 2;
    const size_t tstep = 2 * hstep;
    const unsigned ldsw = (unsigned)wid * 1024u;
    const int aoff = lds_byte(wr * 64 + fr, fq * 8), boff = lds_byte(wc * 32 + fr, fq * 8);
#define PG8_SA(b, h) (((b) * 2 + (h)) * HTB)
#define PG8_SB(b, h) ((4 + (b) * 2 + (h)) * HTB)
#define PG8_STAGE(bufoff, gbase, voff) do { _Pragma("unroll") for (int _i = 0; _i < 2; ++_i) \
        __builtin_amdgcn_global_load_lds((const unsigned*)((const char*)(gbase) + (voff)[_i]), (PG8_LAS unsigned*)(lds + (bufoff) + ldsw + _i * 8192), 16, 0, 0); } while (0)
#define PG8_LDA(dst, b, h) do { _Pragma("unroll") for (int m = 0; m < 4; ++m) _Pragma("unroll") for (int k = 0; k < 2; ++k) dst[m][k] = *(const PG8_LAS bf16x8*)(lds + PG8_SA(b, h) + aoff + m * 2048 + k * 1024); } while (0)
#define PG8_LDB(dst, b, h) do { _Pragma("unroll") for (int n = 0; n < 2; ++n) _Pragma("unroll") for (int k = 0; k < 2; ++k) dst[n][k] = *(const PG8_LAS bf16x8*)(lds + PG8_SB(b, h) + boff + n * 2048 + k * 1024); } while (0)
#define PG8_MMA(ai, bj, At, Bt) do { __builtin_amdgcn_s_setprio(1); _Pragma("unroll") for (int m = 0; m < 4; ++m) _Pragma("unroll") for (int n = 0; n < 2; ++n) _Pragma("unroll") for (int k = 0; k < 2; ++k) \
        acc[ai][bj][m][n] = __builtin_amdgcn_mfma_f32_16x16x32_bf16(Bt[n][k], At[m][k], acc[ai][bj][m][n], 0, 0, 0); __builtin_amdgcn_s_setprio(0); } while (0)
#define PG8_WAIT_V(n) asm volatile("s_waitcnt vmcnt(" #n ")" ::: "memory")
#define PG8_WAIT_L(n) asm volatile("s_waitcnt lgkmcnt(" #n ")" ::: "memory")
#define PG8_BAR __builtin_amdgcn_s_barrier()
#define PG8_SCHED __builtin_amdgcn_sched_barrier(0)
    Unit cur, nxt; int ui = 0;
    if (!S.next(0, cur)) return;
    f32x4 acc[2][2][4][2];
#pragma unroll
    for (int a = 0; a < 2; ++a)
#pragma unroll
        for (int b = 0; b < 2; ++b)
#pragma unroll
            for (int m = 0; m < 4; ++m)
#pragma unroll
                for (int n = 0; n < 2; ++n) acc[a][b][m][n] = (f32x4){0.f, 0.f, 0.f, 0.f};
    bf16x8 At[4][2], B0[2][2], B1[2][2];
    const char* cA = (const char*)g.A + (size_t)cur.pm * tstep; const char* cB = (const char*)g.Bt + (size_t)cur.pn * tstep;
    S.a_ready(cur);
    if constexpr (SP2) {
        PG8_STAGE(PG8_SB(0, 0), cB, voffB); PG8_STAGE(PG8_SB(0, 1), cB + hstep, voffB); PG8_STAGE(PG8_SA(0, 0), cA, voffA); PG8_STAGE(PG8_SA(0, 1), cA + hstep, voffA);
        if (wr == 1) PG8_BAR;
        PG8_WAIT_V(2); PG8_BAR;
        PG8_STAGE(PG8_SB(1, 0), cB + kstep, voffB); PG8_STAGE(PG8_SA(1, 0), cA + kstep, voffA); PG8_STAGE(PG8_SB(1, 1), cB + hstep + kstep, voffB);
        PG8_WAIT_V(6); PG8_BAR;
    } else {
        PG8_STAGE(PG8_SB(0, 0), cB, voffB); PG8_STAGE(PG8_SA(0, 0), cA, voffA); PG8_STAGE(PG8_SB(0, 1), cB + hstep, voffB); PG8_STAGE(PG8_SA(0, 1), cA + hstep, voffA);
        if (wr == 1) PG8_BAR;
        PG8_WAIT_V(4); PG8_BAR;
        PG8_STAGE(PG8_SB(1, 0), cB + kstep, voffB); PG8_STAGE(PG8_SA(1, 0), cA + kstep, voffA); PG8_STAGE(PG8_SB(1, 1), cB + hstep + kstep, voffB);
        PG8_WAIT_V(6); PG8_BAR;
    }
    for (;;) {
        const bool has_next = S.next(ui + 1, nxt);
        const char* nA = has_next ? (const char*)g.A + (size_t)nxt.pm * tstep : cA; const char* nB = has_next ? (const char*)g.Bt + (size_t)nxt.pn * tstep : cB;
        for (int t = 0; t < nt; t += 2) {
            const bool last = (t == nt - 2);
            const char* a1 = cA + (size_t)(t + 1) * kstep;
            const char* a2 = last ? nA : cA + (size_t)(t + 2) * kstep; const char* b2 = last ? nB : cB + (size_t)(t + 2) * kstep;
            const char* a3 = a2 + kstep; const char* b3 = b2 + kstep;
            if (last && has_next) S.a_ready(nxt);
            if constexpr (SP2) {
            PG8_LDB(B0, 0, 0); PG8_LDB(B1, 0, 1); PG8_SCHED; PG8_LDA(At, 0, 0); PG8_STAGE(PG8_SA(1, 1), a1 + hstep, voffA);
            PG8_WAIT_V(8); PG8_WAIT_L(0); PG8_BAR; PG8_MMA(0, 0, At, B0); PG8_MMA(0, 1, At, B1); PG8_BAR; PG8_SCHED;
            PG8_LDA(At, 0, 1); PG8_STAGE(PG8_SB(0, 0), b2, voffB); PG8_STAGE(PG8_SB(0, 1), b2 + hstep, voffB); PG8_STAGE(PG8_SA(0, 0), a2, voffA);
            PG8_WAIT_V(8); PG8_WAIT_L(0); PG8_BAR; PG8_MMA(1, 0, At, B0); PG8_MMA(1, 1, At, B1); PG8_BAR; PG8_SCHED;
            PG8_LDB(B0, 1, 0); PG8_LDB(B1, 1, 1); PG8_SCHED; PG8_LDA(At, 1, 0); PG8_STAGE(PG8_SA(0, 1), a2 + hstep, voffA);
            PG8_WAIT_V(8); PG8_WAIT_L(0); PG8_BAR; PG8_MMA(0, 0, At, B0); PG8_MMA(0, 1, At, B1); PG8_BAR; PG8_SCHED;
            PG8_LDA(At, 1, 1); PG8_STAGE(PG8_SB(1, 0), b3, voffB); PG8_STAGE(PG8_SB(1, 1), b3 + hstep, voffB); PG8_STAGE(PG8_SA(1, 0), a3, voffA);
            PG8_WAIT_V(8); PG8_WAIT_L(0); PG8_BAR; PG8_MMA(1, 0, At, B0); PG8_MMA(1, 1, At, B1); PG8_BAR; PG8_SCHED;
            } else {
            PG8_LDB(B0, 0, 0); PG8_SCHED; PG8_LDA(At, 0, 0); PG8_STAGE(PG8_SA(1, 1), a1 + hstep, voffA);
            PG8_WAIT_L(8); PG8_BAR; PG8_WAIT_L(0); PG8_MMA(0, 0, At, B0); PG8_BAR; PG8_SCHED;
            PG8_LDB(B1, 0, 1); PG8_STAGE(PG8_SB(0, 0), b2, voffB);
            PG8_BAR; PG8_WAIT_L(0); PG8_MMA(0, 1, At, B1); PG8_BAR;
            PG8_LDA(At, 0, 1); PG8_STAGE(PG8_SA(0, 0), a2, voffA);
            PG8_BAR; PG8_WAIT_L(0); PG8_MMA(1, 0, At, B0); PG8_BAR; PG8_SCHED;
            PG8_STAGE(PG8_SB(0, 1), b2 + hstep, voffB);
            PG8_WAIT_V(6); PG8_BAR; PG8_MMA(1, 1, At, B1); PG8_BAR;
            PG8_LDB(B0, 1, 0); PG8_SCHED; PG8_LDA(At, 1, 0); PG8_STAGE(PG8_SA(0, 1), a2 + hstep, voffA);
            PG8_WAIT_L(8); PG8_BAR; PG8_WAIT_L(0); PG8_MMA(0, 0, At, B0); PG8_BAR; PG8_SCHED;
            PG8_LDB(B1, 1, 1); PG8_STAGE(PG8_SB(1, 0), b3, voffB);
            PG8_BAR; PG8_WAIT_L(0); PG8_MMA(0, 1, At, B1); PG8_BAR;
            PG8_LDA(At, 1, 1); PG8_STAGE(PG8_SA(1, 0), a3, voffA);
            PG8_BAR; PG8_WAIT_L(0); PG8_MMA(1, 0, At, B0); PG8_BAR; PG8_SCHED;
            PG8_STAGE(PG8_SB(1, 1), b3 + hstep, voffB);
            PG8_WAIT_V(6); PG8_BAR; PG8_MMA(1, 1, At, B1); PG8_BAR;
            }
        }
        if constexpr (ALIGN_EPI) { if (wr == 0) PG8_BAR; }
        if constexpr (!Epi::AFTER_DRAIN) { E(acc, cur, wr, wc, fr, fq); S.done(cur); }
        if (!has_next) break;
#pragma unroll
        for (int a = 0; a < 2; ++a)
#pragma unroll
            for (int b = 0; b < 2; ++b)
#pragma unroll
                for (int m = 0; m < 4; ++m)
#pragma unroll
                    for (int n = 0; n < 2; ++n) acc[a][b][m][n] = (f32x4){0.f, 0.f, 0.f, 0.f};
        cur = nxt; cA = nA; cB = nB; ++ui;
        if constexpr (ALIGN_EPI) { if (wr == 1) PG8_BAR; }
    }
    PG8_WAIT_V(0);
    if constexpr (!ALIGN_EPI) { if (wr == 0) PG8_BAR; }
    PG8_BAR;
    if constexpr (Epi::AFTER_DRAIN) { E.fused(acc, cur, wr, wc, fr, fq, lds, wid, lane); S.done(cur); }
#undef PG8_SA
#undef PG8_SB
#undef PG8_STAGE
#undef PG8_LDA
#undef PG8_LDB
#undef PG8_MMA
#undef PG8_WAIT_V
#undef PG8_WAIT_L
#undef PG8_BAR
#undef PG8_SCHED
}
}

#define LAS __attribute__((address_space(3)))
typedef LAS unsigned char* ldsp;
typedef unsigned short bf16;
typedef short bf16x8 __attribute__((ext_vector_type(8)));
typedef short s16x4 __attribute__((ext_vector_type(4)));
typedef float f32x16 __attribute__((ext_vector_type(16)));
typedef float f32x4 __attribute__((ext_vector_type(4)));
typedef float f32x2 __attribute__((ext_vector_type(2)));
typedef unsigned u32x4 __attribute__((ext_vector_type(4)));
typedef unsigned u32x2 __attribute__((ext_vector_type(2)));
typedef __bf16 bf16x2_t __attribute__((ext_vector_type(2)));
__device__ __forceinline__ unsigned cvtpk(float lo, float hi) { f32x2 v = {lo, hi}; bf16x2_t b = __builtin_convertvector(v, bf16x2_t); return __builtin_bit_cast(unsigned, b); }
__device__ __forceinline__ float bf_lo(unsigned u) { return __uint_as_float(u << 16); }
__device__ __forceinline__ float bf_hi(unsigned u) { return __uint_as_float(u & 0xffff0000u); }
__device__ __forceinline__ float swap32_max(float m) { auto rr = __builtin_amdgcn_permlane32_swap(__float_as_uint(m), __float_as_uint(m), false, false); return fmaxf(__uint_as_float(rr[0]), __uint_as_float(rr[1])); }
__device__ __forceinline__ float swap32_sum(float m) { auto rr = __builtin_amdgcn_permlane32_swap(__float_as_uint(m), __float_as_uint(m), false, false); return __uint_as_float(rr[0]) + __uint_as_float(rr[1]); }
__device__ __forceinline__ int crow(int r, int hi) { return (r & 3) + 8 * (r >> 2) + 4 * hi; }
typedef short v4i16_t __attribute__((ext_vector_type(4)));
__device__ __forceinline__ s16x4 vtr(ldsp p) { return __builtin_bit_cast(s16x4, __builtin_amdgcn_ds_read_tr16_b64_v4i16((LAS v4i16_t*)p)); }
__device__ __forceinline__ float wave_sum(float v) {
#pragma unroll
    for (int o = 1; o < 64; o <<= 1) v += __shfl_xor(v, o);
    return v;
}

constexpr size_t MiB = 1u << 20;
constexpr size_t WS_CTL = 0;
constexpr size_t WS_LAM = 4096;
constexpr size_t WS_UNITS = 8192;
constexpr size_t WS_BAR = 32 * 1024;
constexpr size_t WS_SUMSQ = 64 * 1024;
constexpr size_t WS_CUMTOT = 512 * 1024;
constexpr size_t WS_CUMLOC = 1 * MiB;
constexpr size_t WS_HSIDE = 2 * MiB;
constexpr size_t WS_ROPE = 3 * MiB;
constexpr size_t WS_WIN = 6 * MiB;
constexpr size_t WS_WOUT = 22 * MiB;
constexpr size_t WS_HB = 26 * MiB;
constexpr size_t WS_MIX = 59 * MiB;
constexpr size_t WS_P = 92 * MiB;
constexpr size_t WS_END = 223 * MiB;
static_assert(WS_HB + (size_t)MR * DM * 2 <= WS_MIX && WS_MIX + (size_t)MR * DM * 2 <= WS_P && WS_P + (size_t)MR * NP * 2 <= WS_END, "ws map");
constexpr int N_DIFF_UNITS = 8 * 65, N_FOX_UNITS = 16 * 33, N_UNITS = N_DIFF_UNITS + N_FOX_UNITS;

constexpr int LDS_BYTES = 147456;
constexpr int LDS_PREF = 132 * 1024, LDS_MISC = 133 * 1024;

struct Frame {
    const float *x, *meta, *norm_g, *w_in, *b_forget, *lq1, *lk1, *lq2, *lk2, *subln_g, *w_out, *final_g;
    float* out; unsigned char* ws;
    unsigned* ctl; float* lam; int* units; float* sumsq; float* cumtot; float* cumloc; float* hside; float* rope;
    bf16 *win_t, *wout_t, *hb, *mix, *P, *mixm;
    ldsp lds; int tid, lane, wave, G, bid;
};

__device__ __forceinline__ unsigned f2bf(float f) { unsigned u = __float_as_uint(f); return (u + 0x7fffu + ((u >> 16) & 1u)) >> 16; }
__device__ __forceinline__ unsigned pk2(float lo, float hi) { return f2bf(lo) | (f2bf(hi) << 16); }
__device__ __forceinline__ void transpose_item(const float* W, int ldw, bool ropemap, const float* g, bf16* WT, int nN, LAS float* scr, int item, int lane) {
    const int nblk = nN / 32, kb = item / nblk, nb = item % nblk, k0 = 64 * kb, n0 = 32 * nb;
    const int n = n0 + (lane & 31);
    int col = n; if (ropemap && n < 1024) { const int p = n & 63; col = (n & ~63) + (p >> 1) + 32 * (p & 1); }
    float wv_[32];
#pragma unroll
    for (int i = 0; i < 32; ++i) { const int kk = 2 * i + (lane >> 5); wv_[i] = W[(size_t)(k0 + kk) * ldw + col]; }
#pragma unroll
    for (int i = 0; i < 32; ++i) { const int kk = 2 * i + (lane >> 5); const float gv = g ? g[k0 + kk] : 1.f; scr[kk * 33 + (lane & 31)] = wv_[i] * gv; }
    asm volatile("s_waitcnt lgkmcnt(0)" ::: "memory");
    const int c = lane & 7;
#pragma unroll
    for (int j = 0; j < 4; ++j) { const int nn = (lane >> 3) + 8 * j; const LAS float* s = scr + (8 * c) * 33 + nn;
        u32x4 o; o.x = pk2(s[0 * 33], s[1 * 33]); o.y = pk2(s[2 * 33], s[3 * 33]); o.z = pk2(s[4 * 33], s[5 * 33]); o.w = pk2(s[6 * 33], s[7 * 33]);
        *(u32x4*)(WT + (size_t)(n0 + nn) * DM + k0 + 8 * c) = o; }
    asm volatile("s_waitcnt lgkmcnt(0)" ::: "memory");
}
__device__ __forceinline__ int unit_cost(int u, const float* bfg) {
    if (u < N_DIFF_UNITS) { const int qi = u % 65; return (qi == 0 ? 1 : 1 + 2 * qi) * 4; }
    const int v = u - N_DIFF_UNITS, qi = v % 33, h = (v / 33) & 7;
    const float rate = 1.44f * 1.65f * log1pf(expf(-bfg[h]));
    const int wt = 6 + (int)(95.0f / (64.0f * rate));
    const int full = (qi == 0 ? 1 : 1 + 4 * qi);
    return (full < wt ? full : wt) * 3;
}
__device__ __forceinline__ void p0_prologue(Frame& F) {
    const int gw = F.bid * 8 + F.wave, NGW = F.G * 8, gt = F.bid * 512 + F.tid, NGT = F.G * 512;
    LAS float* scr = (LAS float*)(F.lds + F.wave * 16384);
    constexpr int I_IN = 16 * (NP / 32), I_OUT = 16 * (DM / 32);
    for (int it = gw; it < 2 * (I_IN + I_OUT); it += NGW) {
        int r = it; const int l = r / (I_IN + I_OUT); r -= l * (I_IN + I_OUT);
        if (r < I_IN) transpose_item(F.w_in + (size_t)l * DM * PW, PW, true, F.norm_g + l * DM, F.win_t + (size_t)l * NP * DM, NP, scr, r, F.lane);
        else transpose_item(F.w_out + (size_t)l * DM * DM, DM, false, nullptr, F.wout_t + (size_t)l * DM * DM, DM, scr, r - I_IN, F.lane);
    }
    for (int m0 = gw * 4; m0 < MG; m0 += NGW * 4) {
        f32x4 v[4][4];
#pragma unroll
        for (int q = 0; q < 4; ++q)
#pragma unroll
            for (int j = 0; j < 4; ++j) v[q][j] = *(const f32x4*)(F.x + (size_t)(m0 + q) * DM + 4 * F.lane + 256 * j);
#pragma unroll
        for (int q = 0; q < 4; ++q) {
            const int m = m0 + q; float ss = 0.f;
#pragma unroll
            for (int j = 0; j < 4; ++j) {
                u32x2 w; w.x = pk2(v[q][j][0], v[q][j][1]); w.y = pk2(v[q][j][2], v[q][j][3]);
                *(u32x2*)(F.hb + (size_t)m * DM + 4 * F.lane + 256 * j) = w;
                ss += (v[q][j][0] * v[q][j][0] + v[q][j][1] * v[q][j][1]) + (v[q][j][2] * v[q][j][2] + v[q][j][3] * v[q][j][3]);
            }
            ss = wave_sum(ss);
            if (F.lane == 0) { F.sumsq[m] = ss; F.sumsq[MG + m] = 0.f; F.sumsq[2 * MG + m] = 0.f; }
        }
    }
    for (int i = gt; i < NMETA * DM; i += NGT) F.hside[i] = F.meta[i];
    for (int i = gt; i < 2 * 48 * (NP / 8); i += NGT) { const int rr = i / (NP / 8), c8 = i % (NP / 8); const int R = (rr / 48) * LP + (rr % 48);
        *(u32x4*)(F.P + (size_t)R * NP + c8 * 8) = (u32x4){0u, 0u, 0u, 0u}; }
    for (int i = gt; i < 8208 * 32; i += NGT) {
        const int pos = i >> 5, j = i & 31;
        const double inv = exp2(-(double)j * (13.287712379549449 / 32.0));
        const double ang = (double)pos * inv;
        double s, c; sincos(ang, &s, &c);
        F.rope[2 * i] = (float)c; F.rope[2 * i + 1] = (float)s;
    }
    if (F.bid == 0) {
        F.ctl[F.tid] = 0u;
        if (F.tid < 2) {
            const int l = F.tid; float s1 = 0.f, s2 = 0.f;
            for (int i = 0; i < 64; ++i) { s1 += F.lq1[l * 64 + i] * F.lk1[l * 64 + i]; s2 += F.lq2[l * 64 + i] * F.lk2[l * 64 + i]; }
            const float li = 0.8f - 0.6f * expf(-0.3f * (float)l);
            F.lam[l] = expf(s1) - expf(s2) + li;
        }
    }
    for (int ul = gw; ul < 2 * N_UNITS; ul += NGW) {
        const int l = ul / N_UNITS, u = ul - l * N_UNITS; const float* bfg = F.b_forget + l * 8;
        const int cu = unit_cost(u, bfg); int cnt = 0;
        for (int v = F.lane; v < N_UNITS; v += 64) { const int cv = unit_cost(v, bfg); cnt += (cv > cu || (cv == cu && v < u)) ? 1 : 0; }
#pragma unroll
        for (int o = 1; o < 64; o <<= 1) cnt += __shfl_xor(cnt, o);
        if (F.lane == 0) F.units[l * N_UNITS + cnt] = u;
    }
}

__device__ __forceinline__ void forget_item(Frame& F, int layer, int tile) {
    const float* W = F.w_in + (size_t)layer * DM * PW + 4096; const float* g = F.norm_g + layer * DM; const float* bfg = F.b_forget + layer * 8;
    ldsp wl = F.lds;
    LAS float* lf = (LAS float*)(F.lds + 40960);
#pragma unroll
    for (int q = 0; q < 2; ++q) { const int kk = F.tid + 512 * q; const float gv = g[kk];
        const f32x4 a = *(const f32x4*)(W + (size_t)kk * PW) * gv, b = *(const f32x4*)(W + (size_t)kk * PW + 4) * gv;
        *(LAS f32x4*)(wl + (kk >> 2) * 144 + (kk & 3) * 32) = a; *(LAS f32x4*)(wl + (kk >> 2) * 144 + (kk & 3) * 32 + 16) = b; }
    __syncthreads();
    const int row_l = F.tid >> 3, kp = F.tid & 7;
    const int fb = tile >> 7, fj = tile & 127; const size_t R0 = (size_t)fb * LP + 64 + 64 * fj;
    const float* xp = (layer == 0 ? F.x : (const float*)F.out) + ((size_t)tile * 64 + row_l) * DM;
    float acc[8] = {0.f, 0.f, 0.f, 0.f, 0.f, 0.f, 0.f, 0.f}; float ss = 0.f;
#pragma unroll 1
    for (int bt = 0; bt < 4; ++bt) {
        f32x4 xv[8];
#pragma unroll
        for (int i = 0; i < 8; ++i) xv[i] = *(const f32x4*)(xp + 4 * (kp + 8 * (bt * 8 + i)));
#pragma unroll
        for (int i = 0; i < 8; ++i) { ldsp wg = wl + (kp + 8 * (bt * 8 + i)) * 144;
#pragma unroll
            for (int e = 0; e < 4; ++e) { const float xe = xv[i][e]; ss += xe * xe;
                const f32x4 wa = *(LAS f32x4*)(wg + e * 32), wb = *(LAS f32x4*)(wg + e * 32 + 16);
                acc[0] += xe * wa[0]; acc[1] += xe * wa[1]; acc[2] += xe * wa[2]; acc[3] += xe * wa[3];
                acc[4] += xe * wb[0]; acc[5] += xe * wb[1]; acc[6] += xe * wb[2]; acc[7] += xe * wb[3]; } }
    }
#pragma unroll
    for (int o = 1; o < 8; o <<= 1) { ss += __shfl_xor(ss, o);
#pragma unroll
        for (int j = 0; j < 8; ++j) acc[j] += __shfl_xor(acc[j], o); }
    float mine = acc[0];
#pragma unroll
    for (int j = 1; j < 8; ++j) mine = (kp == j) ? acc[j] : mine;
    {
        const float xl = mine * rsqrtf(ss * (1.0f / DM) + NORM_EPS) + bfg[kp];
        float v = fminf(xl, 0.f) - log1pf(expf(-fabsf(xl)));
        lf[row_l * 8 + kp] = v;
    }
    __syncthreads();
    if (F.wave == 0) {
        const int seg = F.lane >> 3, j = F.lane & 7;
        float vals[8]; float run = 0.f;
#pragma unroll
        for (int i = 0; i < 8; ++i) { run += lf[(seg * 8 + i) * 8 + j]; vals[i] = run; }
        float inc = run;
#pragma unroll
        for (int o = 8; o < 64; o <<= 1) { const float t_ = __shfl_up(inc, o); if (F.lane >= o) inc += t_; }
        const float excl = inc - run;
#pragma unroll
        for (int i = 0; i < 8; ++i) F.cumloc[(R0 + seg * 8 + i) * 8 + j] = (excl + vals[i]) * LOG2E;
        if (seg == 7) F.cumtot[(fb * TPB + 1 + fj) * 8 + j] = inc * LOG2E;
    }
    __syncthreads();
}

template <int MODE>
__device__ __forceinline__ void meta_item(Frame& F, int layer, int item) {
    LAS float* xT = (LAS float*)(F.lds);
    LAS float* red = (LAS float*)(F.lds + 65536);
    LAS float* rr = (LAS float*)(F.lds + 98304);
    LAS float* lfm = (LAS float*)(F.lds + 98304 + 256);
    const float* W = MODE == 0 ? F.w_in + (size_t)layer * DM * PW : F.w_out + (size_t)layer * DM * DM;
    const int ldw = MODE == 0 ? PW : DM;
    const float* g = F.norm_g + layer * DM;
    for (int idx = F.tid; idx < NMETA * DM; idx += 512) { const int row = idx >> 10, k = idx & 1023;
        float v; if (MODE == 0) v = F.hside[idx]; else v = __uint_as_float((unsigned)F.mixm[idx] << 16);
        xT[k * 16 + row] = v; }
    __syncthreads();
    if (MODE == 0) {
        const int row = F.tid >> 5, l32 = F.tid & 31; float ss = 0.f;
#pragma unroll 8
        for (int i = 0; i < 32; ++i) { const float v = xT[(l32 + 32 * i) * 16 + row]; ss += v * v; }
#pragma unroll
        for (int o = 1; o < 32; o <<= 1) ss += __shfl_xor(ss, o);
        if (l32 == 0) rr[row] = rsqrtf(ss * (1.0f / DM) + NORM_EPS);
    }
    const int c = F.tid & 15, ks = F.tid >> 4;
    const int n = item * 16 + c;
    int col = n; bool colok = true;
    if (MODE == 0) { if (n < 1024) { const int p = n & 63; col = (n & ~63) + (p >> 1) + 32 * (p & 1); } colok = n < PW; if (!colok) col = 0; }
    float acc[16];
#pragma unroll
    for (int r = 0; r < 16; ++r) acc[r] = 0.f;
#pragma unroll 1
    for (int k8 = 0; k8 < 4; ++k8) {
        float wv[8];
#pragma unroll
        for (int i = 0; i < 8; ++i) { const int k = ks * 32 + k8 * 8 + i; wv[i] = W[(size_t)k * ldw + col] * (MODE == 0 ? g[k] : 1.f); }
#pragma unroll
        for (int i = 0; i < 8; ++i) { const int k = ks * 32 + k8 * 8 + i;
#pragma unroll
            for (int q = 0; q < 4; ++q) { const f32x4 xv = *(LAS f32x4*)(xT + k * 16 + 4 * q);
                acc[4 * q] += wv[i] * xv[0]; acc[4 * q + 1] += wv[i] * xv[1]; acc[4 * q + 2] += wv[i] * xv[2]; acc[4 * q + 3] += wv[i] * xv[3]; } }
    }
#pragma unroll
    for (int r = 0; r < 16; ++r) red[(ks * 16 + r) * 16 + c] = colok ? acc[r] : 0.f;
    __syncthreads();
    if (F.tid < 256) {
        const int r = F.tid >> 4;
        float v = 0.f;
#pragma unroll 8
        for (int s_ = 0; s_ < 32; ++s_) v += red[(s_ * 16 + r) * 16 + c];
        if (MODE == 1) { F.hside[r * DM + n] += v; }
        else {
            v *= rr[r];
            if (item < 256) {
                const int pn = n >> 8;
                const int mode = (pn < 4) ? 1 : ((pn == 6 || pn == 7 || pn >= 14) ? 2 : 0);
                if (pn < 2 || pn == 8 || pn == 9) v *= C2;
                const float partner = __shfl_xor(v, 1);
                if (mode == 1) { const int j = (n & 63) >> 1; const float cs = F.rope[(r * 32 + j) * 2], sn = F.rope[(r * 32 + j) * 2 + 1];
                    v = (n & 1) ? (v * cs + partner * sn) : (v * cs - partner * sn); }
                else if (mode == 2) v = v * __builtin_amdgcn_rcpf(1.f + __builtin_amdgcn_exp2f(-v * LOG2E));
                const bf16 o = (bf16)f2bf(v);
                F.P[((size_t)48 + r) * NP + n] = o; F.P[((size_t)LP + 48 + r) * NP + n] = o;
                if (pn == 10 || pn == 11) {
                    float ss = v * v;
#pragma unroll
                    for (int o2 = 1; o2 < 16; o2 <<= 1) ss += __shfl_xor(ss, o2);
                    if (c == 0) atomicMax(F.ctl + 128 + layer * 128 + 32 + ((n - 2560) >> 4), __float_as_uint(ss));
                }
            } else if (c < 8) {
                const float xl = v + F.b_forget[layer * 8 + c];
                lfm[r * 8 + c] = fminf(xl, 0.f) - log1pf(expf(-fabsf(xl)));
            }
        }
    }
    __syncthreads();
    if (MODE == 0 && item == 256 && F.tid < 8) {
        float run = 0.f;
        for (int pp = 0; pp < 64; ++pp) { if (pp >= 48) run += lfm[(pp - 48) * 8 + F.tid];
            F.cumloc[(size_t)pp * 8 + F.tid] = run * LOG2E; F.cumloc[((size_t)LP + pp) * 8 + F.tid] = run * LOG2E; }
        F.cumtot[F.tid] = run * LOG2E; F.cumtot[TPB * 8 + F.tid] = run * LOG2E;
    }
    __syncthreads();
}

__device__ __forceinline__ void split3(float x, unsigned& h, unsigned& m, unsigned& l) {
    h = cvtpk(x, 0.f) & 0xffffu; const float r1 = x - __uint_as_float(h << 16);
    m = cvtpk(r1, 0.f) & 0xffffu; const float r2 = r1 - __uint_as_float(m << 16);
    l = cvtpk(r2, 0.f) & 0xffffu;
}
struct AttnP { const bf16* P; bf16* mixed; const float* cumloc; const float* cumtot; const float* subg; const unsigned* nrm; bf16* mixm; float lam; float one_m_li; };

template <bool DIFF>
__device__ __forceinline__ void attn_unit(const AttnP& A, int b, int h, int qi, ldsp lds) {
    constexpr int DV = DIFF ? 128 : 64, NTD = DV / 32, KP = DIFF ? 272 : 144, VP = DIFF ? 320 : 192, QROWS = DIFF ? 128 : 256, TPQ = QROWS / 64;
    constexpr int STAGE = 64 * KP + 64 * VP + 256, NPIECE = DIFF ? 2 : 1;
    int tid_ = threadIdx.x; asm volatile("" : "+v"(tid_));
    const int tid = tid_, lane = tid & 63, w = __builtin_amdgcn_readfirstlane(tid >> 6), r32 = lane & 31, hi = lane >> 5;
    const int comp = DIFF ? (w >> 2) : 0, wq = DIFF ? (w & 3) : w;
    const int qstart = qi == 0 ? 0 : 64 + QROWS * (qi - 1);
    const int nt = qi == 0 ? 1 : 1 + TPQ * qi;
    const int diag0 = qi == 0 ? 0 : nt - TPQ;
    const int q_pp = qstart + 32 * wq + r32, qmax_w = qstart + 32 * wq + 31;
    const bool store_ok = (qi != 0) || (b == 0 && q_pp >= 48 && q_pp < 64);
    const size_t Rb = (size_t)b * LP;
    const int qcol = DIFF ? h * 128 + comp * 64 : 2048 + h * 64;
    const int kcol = DIFF ? 512 + h * 128 : 2560 + h * 64;
    const int vcol = DIFF ? 1024 + h * 128 : 3072 + h * 64;
    const int zcol = DIFF ? 1536 + h * 128 : 3584 + h * 64;
    const int mcol = DIFF ? h * 128 : 512 + h * 64;
    const bf16* Pq = A.P + (Rb + q_pp) * NP;
    bf16x8 qf[4];
#pragma unroll
    for (int c = 0; c < 4; ++c) qf[c] = *(const bf16x8*)(Pq + qcol + 16 * c + 8 * hi);
    LAS float* pref = (LAS float*)(lds + LDS_PREF);
    u32x4 kreg[NPIECE], vreg[NPIECE]; float clreg = 0.f;
#define LOAD_TILE(kt) do { const bf16* base_ = A.P + (Rb + 64 * (size_t)(kt)) * NP; \
        _Pragma("unroll") for (int i_ = 0; i_ < NPIECE; ++i_) { const int p_ = tid + 512 * i_; const int row_ = DIFF ? (p_ >> 4) : (p_ >> 3); const int c16_ = DIFF ? (p_ & 15) : (p_ & 7); \
            kreg[i_] = *(const u32x4*)(base_ + (size_t)row_ * NP + kcol + c16_ * 8); vreg[i_] = *(const u32x4*)(base_ + (size_t)row_ * NP + vcol + c16_ * 8); } \
        if (!DIFF && tid < 64) clreg = A.cumloc[(Rb + 64 * (size_t)(kt) + tid) * 8 + h]; } while (0)
#define STORE_TILE(st) do { ldsp sb_ = lds + (st) * STAGE; \
        _Pragma("unroll") for (int i_ = 0; i_ < NPIECE; ++i_) { const int p_ = tid + 512 * i_; const int row_ = DIFF ? (p_ >> 4) : (p_ >> 3); const int c16_ = DIFF ? (p_ & 15) : (p_ & 7); \
            *(LAS u32x4*)(sb_ + row_ * KP + c16_ * 16) = kreg[i_]; *(LAS u32x4*)(sb_ + 64 * KP + row_ * VP + c16_ * 16) = vreg[i_]; } \
        if (!DIFF && tid < 64) { unsigned h_, m_, l_; split3(-clreg, h_, m_, l_); *(LAS u32x4*)(sb_ + tid * KP + 128) = (u32x4){h_ | (m_ << 16), l_ | 0x3f800000u, 0x3f803f80u, 0u}; } } while (0)
    int kt0 = 0;
    if (!DIFF) {
        LAS int* kst = (LAS int*)(lds + LDS_MISC + 64);
        if (tid == 0) *kst = nt - 1;
        if (w == 0) {
            float carry = 0.f;
#pragma unroll
            for (int ch = 0; ch < 3; ++ch) {
                const int idx = ch * 64 + lane;
                const float v = idx < TPB ? A.cumtot[(b * TPB + idx) * 8 + h] : 0.f;
                float inc = v;
#pragma unroll
                for (int o = 1; o < 64; o <<= 1) { const float t_ = __shfl_up(inc, o); if (lane >= o) inc += t_; }
                if (idx < TPB) pref[idx] = carry + inc - v;
                if (idx == TPB - 1) pref[TPB] = carry + inc;
                carry += __shfl(inc, 63);
            }
        }
        __syncthreads();
        const float q2 = __uint_as_float(A.nrm[(h) * 2]) + __uint_as_float(A.nrm[(h) * 2 + 1]), k2r = __uint_as_float(A.nrm[(8 + h) * 2]) + __uint_as_float(A.nrm[(8 + h) * 2 + 1]),
                    k2m = (__uint_as_float(A.nrm[32 + h * 4]) + __uint_as_float(A.nrm[32 + h * 4 + 1])) + (__uint_as_float(A.nrm[32 + h * 4 + 2]) + __uint_as_float(A.nrm[32 + h * 4 + 3])), k2 = fmaxf(k2r, k2m);
        const float thr = 2.0f * 1.03f * sqrtf(q2 * k2) + 40.0f;
        if (tid < nt) { if (pref[qstart >> 6] - pref[tid + 1] >= -thr) atomicMin((int*)kst, tid); }
        __syncthreads();
        kt0 = *kst;
    }
    LOAD_TILE(kt0);
    STORE_TILE(kt0 & 1);
    __syncthreads();
    float cq = 0.f;
    if (!DIFF) cq = pref[q_pp >> 6] + A.cumloc[(Rb + q_pp) * 8 + h];
    float mhat = 0.f, l_run = 0.f;
    f32x16 negm;
#pragma unroll
    for (int r = 0; r < 16; ++r) negm[r] = 0.f;
    f32x16 o[NTD];
#pragma unroll
    for (int t = 0; t < NTD; ++t)
#pragma unroll
        for (int r = 0; r < 16; ++r) o[t][r] = 0.f;
    const int trb = (4 * hi + ((lane & 15) >> 2)) * VP + ((lane >> 4) & 1) * 32 + (lane & 3) * 8;
#pragma unroll
    for (int c = 0; c < 4; ++c) asm volatile("" : "+v"(qf[c]));
    for (int kt = kt0; kt < nt; ++kt) {
        if (kt + 1 < nt) LOAD_TILE(kt + 1);
        if (64 * kt <= qmax_w) {
            ldsp Kb = lds + (kt & 1) * STAGE; ldsp Vb = Kb + 64 * KP;
#define SB() __builtin_amdgcn_sched_barrier(0)
#define MFMA_(a_, b_, c_) __builtin_amdgcn_mfma_f32_32x32x16_bf16((a_), (b_), (c_), 0, 0, 0)
#define MAXH(S) fmaxf(fmaxf(fmaxf(fmaxf(fmaxf(S[0], S[1]), S[2]), fmaxf(fmaxf(S[6], S[7]), fmaxf(fmaxf(S[10], S[11]), fmaxf(S[14], S[15])))), fmaxf(fmaxf(S[3], S[4]), S[5])), fmaxf(fmaxf(S[8], S[9]), fmaxf(S[12], S[13])))
#define EXP4(S, b_) do { _Pragma("unroll") for (int r_ = (b_); r_ < (b_) + 4; ++r_) { S[r_] = __builtin_amdgcn_exp2f(S[r_]); ps += S[r_]; asm("" : "+v"(ps)); } } while (0)
#define CVT8(S, b_) __builtin_bit_cast(bf16x8, (u32x4){cvtpk(S[(b_)], S[(b_) + 1]), cvtpk(S[(b_) + 2], S[(b_) + 3]), cvtpk(S[(b_) + 4], S[(b_) + 5]), cvtpk(S[(b_) + 6], S[(b_) + 7])})
#define MASKH(S, off_) do { _Pragma("unroll") for (int r_ = 0; r_ < 16; ++r_) { const int kpp_ = 64 * kt + (off_) + crow(r_, hi); if (kpp_ < 48 || kpp_ > q_pp) S[r_] = -INFINITY; } } while (0)
#define VREAD(jb_) do { _Pragma("unroll") for (int t_ = 0; t_ < NTD; ++t_) _Pragma("unroll") for (int jj_ = 0; jj_ < 2; ++jj_) { \
                vlo[t_ * 2 + jj_] = vtr(Vb + trb + (16 * ((jb_) + jj_)) * VP + t_ * 64); vhi[t_ * 2 + jj_] = vtr(Vb + trb + (16 * ((jb_) + jj_) + 8) * VP + t_ * 64); } } while (0)
#define PVM(t_, jj_, jb_) do { const int i_ = (t_) * 2 + (jj_); const bf16x8 vf_ = (bf16x8){vlo[i_][0], vlo[i_][1], vlo[i_][2], vlo[i_][3], vhi[i_][0], vhi[i_][1], vhi[i_][2], vhi[i_][3]}; \
                o[(t_)] = MFMA_(vf_, pw[(jb_) + (jj_)], o[(t_)]); } while (0)
            const bool dg = (kt == 0 || kt >= diag0);
            bf16x8 kf[8];
#pragma unroll
            for (int c = 0; c < 4; ++c) {
                kf[2 * c] = *(LAS bf16x8*)(Kb + r32 * KP + comp * 128 + c * 32 + hi * 16);
                kf[2 * c + 1] = *(LAS bf16x8*)(Kb + (32 + r32) * KP + comp * 128 + c * 32 + hi * 16);
            }
            bf16x8 ka0, ka1, qa;
            if (!DIFF) {
                ka0 = *(LAS bf16x8*)(Kb + r32 * KP + 128); ka1 = *(LAS bf16x8*)(Kb + (32 + r32) * KP + 128);
                unsigned h_, m_, l_; split3(cq - pref[kt], h_, m_, l_);
                u32x4 qa_ = (u32x4){0x3f803f80u, 0x3f80u | (h_ << 16), m_ | (l_ << 16), 0u};
                if (hi) qa_ = (u32x4){0u, 0u, 0u, 0u};
                qa = __builtin_bit_cast(bf16x8, qa_);
            }
            SB();
            f32x16 s0 = negm, s1 = negm;
            __builtin_amdgcn_s_setprio(1);
            if (!DIFF) s0 = MFMA_(ka0, qa, s0);
#pragma unroll
            for (int c = 0; c < 4; ++c) s0 = MFMA_(kf[2 * c], qf[c], s0);
            SB();
            s16x4 vlo[2 * NTD], vhi[2 * NTD];
            VREAD(0);
            if (!DIFF) s1 = MFMA_(ka1, qa, s1);
            SB();
            float ps = 0.f, m0, m1;
            bf16x8 pw[4];
            s1 = MFMA_(kf[1], qf[0], s1); SB();
            if (dg) MASKH(s0, 0);
            m0 = MAXH(s0); asm("" : "+v"(m0)); SB();
            s1 = MFMA_(kf[3], qf[1], s1); SB();
            EXP4(s0, 0); SB();
            s1 = MFMA_(kf[5], qf[2], s1); SB();
            EXP4(s0, 4); SB();
            s1 = MFMA_(kf[7], qf[3], s1); SB();
            EXP4(s0, 8); EXP4(s0, 12);
            pw[0] = CVT8(s0, 0); pw[1] = CVT8(s0, 8);
            SB();
            if (DIFF) {
                PVM(0, 0, 0); SB(); if (dg) MASKH(s1, 32); m1 = MAXH(s1); asm("" : "+v"(m1)); SB();
                PVM(1, 0, 0); SB(); EXP4(s1, 0); SB();
                PVM(2, 0, 0); SB(); EXP4(s1, 4); SB();
                PVM(3, 0, 0); SB(); EXP4(s1, 8); SB();
                PVM(0, 1, 0); SB(); EXP4(s1, 12); SB();
                PVM(1, 1, 0); SB(); pw[2] = CVT8(s1, 0); SB();
                PVM(2, 1, 0); SB(); pw[3] = CVT8(s1, 8); SB();
                PVM(3, 1, 0); SB();
            } else {
                PVM(0, 0, 0); SB(); if (dg) MASKH(s1, 32); m1 = MAXH(s1); asm("" : "+v"(m1)); EXP4(s1, 0); SB();
                PVM(1, 0, 0); SB(); EXP4(s1, 4); EXP4(s1, 8); SB();
                PVM(0, 1, 0); SB(); EXP4(s1, 12); pw[2] = CVT8(s1, 0); SB();
                PVM(1, 1, 0); SB(); pw[3] = CVT8(s1, 8); SB();
            }
            VREAD(2);
            const float rm = swap32_max(fmaxf(m0, m1));
            l_run += ps;
            SB();
#pragma unroll
            for (int jj = 0; jj < 2; ++jj)
#pragma unroll
                for (int t = 0; t < NTD; ++t) PVM(t, jj, 2);
            __builtin_amdgcn_s_setprio(0);
            if (__any(rm > 8.0f)) {
                const float dl = fmaxf(rm, 0.f);
                mhat += dl;
#pragma unroll
                for (int r = 0; r < 16; ++r) negm[r] = -mhat;
                const float f = __builtin_amdgcn_exp2f(-dl);
                l_run *= f;
#pragma unroll
                for (int t = 0; t < NTD; ++t)
#pragma unroll
                    for (int r = 0; r < 16; ++r) o[t][r] *= f;
            }
#undef SB
#undef MFMA_
#undef MAXH
#undef EXP4
#undef CVT8
#undef MASKH
#undef VREAD
#undef PVM
        }
        if (kt + 1 < nt) STORE_TILE((kt + 1) & 1);
        __syncthreads();
    }
#undef LOAD_TILE
#undef STORE_TILE
    const float lt = swap32_sum(l_run);
    const float inv = lt > 0.f ? 1.0f / lt : 0.f;
    const size_t Rq = Rb + q_pp;
    bf16* mrow = (qi != 0) ? A.mixed + ((size_t)b * T + (q_pp - 64)) * DM : A.mixm + (size_t)((q_pp - 48) & 15) * DM;
    if (!DIFF) {
        if (store_ok) {
#pragma unroll
            for (int t = 0; t < NTD; ++t)
#pragma unroll
                for (int g = 0; g < 4; ++g) {
                    const int dv0 = 32 * t + 8 * g + 4 * hi;
                    const u32x2 z = *(const u32x2*)(A.P + Rq * NP + zcol + dv0);
                    u32x2 wv; wv.x = cvtpk(o[t][4 * g] * inv * bf_lo(z.x), o[t][4 * g + 1] * inv * bf_hi(z.x)); wv.y = cvtpk(o[t][4 * g + 2] * inv * bf_lo(z.y), o[t][4 * g + 3] * inv * bf_hi(z.y));
                    *(u32x2*)(mrow + mcol + dv0) = wv;
                }
        }
    } else {
        LAS float* xch = (LAS float*)lds;
        if (comp == 1) {
            const float f = inv * A.lam;
#pragma unroll
            for (int t = 0; t < NTD; ++t)
#pragma unroll
                for (int r = 0; r < 16; ++r) xch[(t * 16 + r) * 256 + wq * 64 + lane] = o[t][r] * f;
        }
        __syncthreads();
        if (comp == 0) {
            float ss = 0.f;
#pragma unroll
            for (int t = 0; t < NTD; ++t)
#pragma unroll
                for (int r = 0; r < 16; ++r) { const float v = o[t][r] * inv - xch[(t * 16 + r) * 256 + wq * 64 + lane]; o[t][r] = v; ss += v * v; }
            ss = swap32_sum(ss);
            const float rn = rsqrtf(ss * (1.0f / 128.0f) + NORM_EPS) * A.one_m_li;
            if (store_ok) {
#pragma unroll
                for (int t = 0; t < NTD; ++t)
#pragma unroll
                    for (int g = 0; g < 4; ++g) {
                        const int dv0 = 32 * t + 8 * g + 4 * hi;
                        const u32x2 z = *(const u32x2*)(A.P + Rq * NP + zcol + dv0);
                        const f32x4 sg = *(const f32x4*)(A.subg + h * 128 + dv0);
                        u32x2 wv; wv.x = cvtpk(o[t][4 * g] * rn * sg[0] * bf_lo(z.x), o[t][4 * g + 1] * rn * sg[1] * bf_hi(z.x));
                        wv.y = cvtpk(o[t][4 * g + 2] * rn * sg[2] * bf_lo(z.y), o[t][4 * g + 3] * rn * sg[3] * bf_hi(z.y));
                        *(u32x2*)(mrow + mcol + dv0) = wv;
                    }
            }
        }
        __syncthreads();
    }
}

__device__ __forceinline__ void attn_phase(Frame& F, int layer, int rep) {
    AttnP A; A.P = F.P; A.mixed = F.mix; A.cumloc = F.cumloc; A.cumtot = F.cumtot; A.subg = F.subln_g + layer * 512; A.nrm = F.ctl + 128 + layer * 128; A.mixm = F.mixm;
    A.lam = F.lam[layer]; A.one_m_li = 1.0f - (0.8f - 0.6f * expf(-0.3f * (float)layer));
    LAS int* cur = (LAS int*)(F.lds + LDS_MISC);
    unsigned* counter = F.ctl + 16 * (layer + 1) + 4 * rep;
    for (;;) {
        if (F.tid == 0) *cur = (int)atomicAdd(counter, 1u);
        __syncthreads();
        const int idx = *cur;
        __syncthreads();
        if (idx >= N_UNITS) break;
        const int u = F.units[layer * N_UNITS + idx];
        if (u < N_DIFF_UNITS) {
#ifndef NO_DIFF
            const int bh = u / 65, qi = u % 65; attn_unit<true>(A, bh >> 2, bh & 3, qi, F.lds);
#endif
        }
#ifndef NO_FOX
        else { const int v = u - N_DIFF_UNITS; const int bh = v / 33, qi = v % 33; attn_unit<false>(A, bh >> 3, bh & 7, qi, F.lds); }
#endif
    }
}

__device__ __forceinline__ void final_phase(Frame& F) {
    const int gw = F.bid * 8 + F.wave, NGW = F.G * 8;
    for (int m = gw; m < NB * T; m += NGW) {
        const float rs = rsqrtf(F.sumsq[2 * MG + m] * (1.0f / DM) + NORM_EPS);
        float* p = F.out + (size_t)m * DM;
#pragma unroll
        for (int j = 0; j < 4; ++j) { const f32x4 v = *(const f32x4*)(p + 4 * F.lane + 256 * j); const f32x4 g = *(const f32x4*)(F.final_g + 4 * F.lane + 256 * j); *(f32x4*)(p + 4 * F.lane + 256 * j) = v * rs * g; }
    }
}

#define XB_TMO      128
#define XB_XCNT(j)  (256  + 64 * (j))
#define XB_XSUB(j)  (1280 + 64 * (j))
#define XB_XGEN(j)  (2304 + 64 * (j))
#define XB_TOP      3328
#define XB_TOPGEN   3392
#define XCD_BAR_WORDS 3456
#define XB_SPIN_CAP (1u << 18)

__device__ __forceinline__ unsigned xb_ld(unsigned* p)              { return __hip_atomic_load(p, __ATOMIC_RELAXED, __HIP_MEMORY_SCOPE_AGENT); }
__device__ __forceinline__ unsigned xb_add(unsigned* p, unsigned v) { return __hip_atomic_fetch_add(p, v, __ATOMIC_RELAXED, __HIP_MEMORY_SCOPE_AGENT); }
__device__ __forceinline__ unsigned xb_xcc_id() { return (unsigned)__builtin_amdgcn_s_getreg((3 << 11) | 20) & 0xFu; }
#define XB_SPIN(cond, bar) do { unsigned _sp = 0; while (cond) { __builtin_amdgcn_s_sleep(1); \
    if ((++_sp & 255u) == 0u) { if (xb_ld(&(bar)[XB_TMO])) break; if (_sp > XB_SPIN_CAP) { atomicAdd(&(bar)[XB_TMO], 1u); break; } } } } while (0)

struct XcdBarrier {
    unsigned* bar; unsigned x;
    volatile LAS unsigned* st;
};

__device__ __forceinline__ XcdBarrier xcd_barrier_post(unsigned* bar, volatile LAS unsigned* st) {
    XcdBarrier b; b.bar = bar; b.x = xb_xcc_id(); b.st = st;
    if (threadIdx.x == 0) (void)xb_add(&bar[XB_XCNT(b.x)], 1u);
    return b;
}
__device__ __forceinline__ void xcd_barrier_complete(unsigned* bar, unsigned x, unsigned& nloc, unsigned& nx) {
    const unsigned G = gridDim.x * gridDim.y * gridDim.z;
    unsigned sum, cnt, mine, sp = 0u;
    for (;;) {
        sum = 0u; cnt = 0u; mine = 0u;
#pragma unroll
        for (unsigned j = 0; j < 16; ++j) { const unsigned c = xb_ld(&bar[XB_XCNT(j)]); sum += c; cnt += (c > 0u) ? 1u : 0u; mine = (j == x) ? c : mine; }
        if (sum == G) break;
        __builtin_amdgcn_s_sleep(1);
        if ((++sp & 255u) == 0u) { if (xb_ld(&bar[XB_TMO])) break; if (sp > XB_SPIN_CAP) { atomicAdd(&bar[XB_TMO], 1u); break; } }
    }
    nloc = mine > 0u ? mine : 1u; nx = cnt > 0u ? cnt : 1u;
}

__device__ __forceinline__ void xcd_barrier(const XcdBarrier& b) {
    asm volatile("s_waitcnt vmcnt(0)" ::: "memory");
    __syncthreads();
    if (threadIdx.x == 0) {
        unsigned* bar = b.bar;
        __builtin_amdgcn_s_waitcnt(0);
        unsigned nloc = b.st[0], nx = b.st[1];
        if (nloc == 0u) { xcd_barrier_complete(bar, b.x, nloc, nx); b.st[0] = nloc; b.st[1] = nx; }
        const unsigned old = xb_add(&bar[XB_XSUB(b.x)], 1u);
        const unsigned gen = old / nloc;
        if (old + 1u == (gen + 1u) * nloc) {
            __builtin_amdgcn_fence(__ATOMIC_RELEASE, "agent");
            asm volatile("s_waitcnt vmcnt(0)" ::: "memory");
            const unsigned og = xb_add(&bar[XB_TOP], 1u);
            const unsigned tg = og / nx;
            if (og + 1u == (tg + 1u) * nx) xb_add(&bar[XB_TOPGEN], 1u);
            else XB_SPIN(xb_ld(&bar[XB_TOPGEN]) == tg, bar);
            __builtin_amdgcn_fence(__ATOMIC_ACQUIRE, "agent");
            xb_add(&bar[XB_XGEN(b.x)], 1u);
            asm volatile("s_waitcnt vmcnt(0)" ::: "memory");
        } else {
            XB_SPIN(xb_ld(&bar[XB_XGEN(b.x)]) == gen, bar);
            __builtin_amdgcn_fence(__ATOMIC_ACQUIRE, "agent");
            asm volatile("s_waitcnt vmcnt(0)" ::: "memory");
        }
    }
    __syncthreads();
}

struct Args { const float* in[12]; float* out; unsigned char* ws; int ph_lo, ph_hi; };
typedef const __attribute__((address_space(4))) Args* kargp;
__device__ __forceinline__ void make_frame(Frame& F, ldsp lds) {
    kargp ap = (kargp)__builtin_amdgcn_kernarg_segment_ptr();
    asm volatile("" : "+s"(ap));
    int tid = threadIdx.x; asm volatile("" : "+v"(tid));
    F.lds = lds; F.tid = tid; F.lane = tid & 63; F.wave = __builtin_amdgcn_readfirstlane(tid >> 6); F.G = gridDim.x; F.bid = blockIdx.x;
    F.x = ap->in[0]; F.meta = ap->in[1]; F.norm_g = ap->in[2]; F.w_in = ap->in[3]; F.b_forget = ap->in[4]; F.lq1 = ap->in[5]; F.lk1 = ap->in[6]; F.lq2 = ap->in[7]; F.lk2 = ap->in[8];
    F.subln_g = ap->in[9]; F.w_out = ap->in[10]; F.final_g = ap->in[11]; F.out = ap->out; F.ws = ap->ws;
    unsigned char* ws = ap->ws;
    F.ctl = (unsigned*)(ws + WS_CTL); F.lam = (float*)(ws + WS_LAM); F.units = (int*)(ws + WS_UNITS); F.sumsq = (float*)(ws + WS_SUMSQ); F.cumtot = (float*)(ws + WS_CUMTOT); F.cumloc = (float*)(ws + WS_CUMLOC);
    F.hside = (float*)(ws + WS_HSIDE); F.rope = (float*)(ws + WS_ROPE); F.win_t = (bf16*)(ws + WS_WIN); F.wout_t = (bf16*)(ws + WS_WOUT); F.hb = (bf16*)(ws + WS_HB); F.mix = (bf16*)(ws + WS_MIX); F.P = (bf16*)(ws + WS_P); F.mixm = (bf16*)(ws + WS_HSIDE + 128 * 1024);
}
__global__ void __launch_bounds__(512) hymba_fwd(Args args) {
    extern __shared__ __attribute__((aligned(16))) unsigned char lds_raw[];
    const ldsp lds = (ldsp)lds_raw;
    const int lo = args.ph_lo, hi = args.ph_hi;
    const bool fuse_final = (lo == 0 && hi == 8 && gridDim.x == 256);
    volatile LAS unsigned* bst = (volatile LAS unsigned*)(lds + LDS_MISC + 128);
    if (threadIdx.x < 2) bst[threadIdx.x] = 0u;
    __syncthreads();
    XcdBarrier xbar; xbar.bar = (unsigned*)(args.ws + WS_BAR); xbar.x = 0; xbar.st = bst;
    if (hi - lo > 1) xbar = xcd_barrier_post((unsigned*)(args.ws + WS_BAR), bst);
    if (lo < 0) cg::this_grid().sync();
#define IN(k) (lo <= (k) && (k) < hi)
#define SEAM(k) do { if (IN(k) && IN((k) + 1)) { xcd_barrier(xbar); } } while (0)
#ifndef REP_PRO
#define REP_PRO 1
#endif
#ifndef REP_IN
#define REP_IN 1
#endif
#ifndef REP_ATTN
#define REP_ATTN 1
#endif
    if (IN(0)) { for (int rep = 0; rep < REP_PRO; ++rep) { Frame F; make_frame(F, lds); p0_prologue(F); if (rep + 1 < REP_PRO) xcd_barrier(xbar); } }
    SEAM(0);
#pragma unroll 1
    for (int layer = 0; layer < 2; ++layer) {
        const int pb = 1 + 3 * layer;
        if (IN(pb)) { for (int rep = 0; rep < REP_IN; ++rep) {
#ifndef NO_FORGET
            { Frame F; make_frame(F, lds); for (int tile = F.bid; tile < MG / 64; tile += F.G) forget_item(F, layer, tile);
              for (int it = F.G - 1 - F.bid; it < 257; it += F.G) meta_item<0>(F, layer, it); }
#endif
#ifndef NO_GIN
            { Frame F; make_frame(F, lds);
              pg8::Gemm g{F.hb, F.win_t + (size_t)layer * NP * DM, MG, NP, DM}; pg8::StaticOrder S; S.init(MG, NP, F.G, F.bid);
              pg8::EpiIn E{F.P, F.sumsq + layer * MG, F.rope, F.ctl + 128 + layer * 128};
              pg8::gemm_phase<pg8::EpiIn, pg8::StaticOrder, true, true>(F.lds, g, S, E); }
#endif
        } }
        SEAM(pb);
        if (IN(pb + 1)) { for (int rep = 0; rep < REP_ATTN; ++rep) { Frame F; make_frame(F, lds); attn_phase(F, layer, rep); } }
        SEAM(pb + 1);
        if (IN(pb + 2)) {
#ifndef NO_GOUT
            Frame F; make_frame(F, lds);
            if (layer == 0) { for (int it = F.bid; it < DM / 16; it += F.G) meta_item<1>(F, layer, it); }
            pg8::Gemm g{F.mix, F.wout_t + (size_t)layer * DM * DM, MG, DM, DM}; pg8::StaticOrder S; S.init(MG, DM, F.G, F.bid);
            if (layer == 1 && fuse_final) {
                pg8::EpiOutFinal E{(const float*)F.out, F.out, F.sumsq + 2 * MG, F.ctl + 448, F.final_g};
                pg8::gemm_phase<pg8::EpiOutFinal, pg8::StaticOrder, true, true>(F.lds, g, S, E);
            } else {
                pg8::EpiOut E{layer == 0 ? F.x : (const float*)F.out, F.out, F.hb, F.sumsq + (layer + 1) * MG, layer == 0 ? 1 : 0};
                pg8::gemm_phase<pg8::EpiOut, pg8::StaticOrder, true, true>(F.lds, g, S, E);
            }
#endif
        }
        if (!(layer == 1 && fuse_final)) SEAM(pb + 2);
    }
    if (IN(7) && !fuse_final) { Frame F; make_frame(F, lds); final_phase(F); }
#undef IN
#undef SEAM
}

extern "C" void kernel_launch(void* const* d_in, const int* in_sizes, int n_in, void* d_out, int out_size, void* d_ws, size_t ws_size, hipStream_t stream) {
    static int grid = 0;
    if (grid == 0) {
        if (n_in != 12 || out_size != NB * T * DM || ws_size < WS_END) { fprintf(stderr, "kernel_launch: unexpected shapes (n_in %d out %d ws %zu)\n", n_in, out_size, ws_size); grid = -1; return; }
        int dev = 0, cus = 0, per_cu = 0;
        (void)hipGetDevice(&dev); (void)hipDeviceGetAttribute(&cus, hipDeviceAttributeMultiprocessorCount, dev);
        if (hipFuncSetAttribute((const void*)hymba_fwd, hipFuncAttributeMaxDynamicSharedMemorySize, LDS_BYTES) != hipSuccess) { fprintf(stderr, "kernel_launch: hipFuncSetAttribute failed\n"); grid = -1; return; }
        if (hipOccupancyMaxActiveBlocksPerMultiprocessor(&per_cu, (const void*)hymba_fwd, 512, LDS_BYTES) != hipSuccess || per_cu < 1) per_cu = 1;
        (void)hipGetLastError();
        grid = cus * per_cu;
        if (grid <= 0) grid = 256;
    }
    if (grid < 0) return;
    Args a{};
    for (int i = 0; i < 12; ++i) a.in[i] = (const float*)d_in[i];
    a.out = (float*)d_out; a.ws = (unsigned char*)d_ws;
#if MK_SINGLE
    (void)hipMemsetAsync((unsigned char*)d_ws + WS_BAR, 0, 16384, stream);
    a.ph_lo = 0; a.ph_hi = 8;
    void* kargs[] = {&a};
    hipError_t e = hipLaunchCooperativeKernel((const void*)hymba_fwd, dim3(grid), dim3(512), kargs, LDS_BYTES, stream);
    if (e != hipSuccess) fprintf(stderr, "cooperative launch failed: %s (grid %d)\n", hipGetErrorString(e), grid);
#else
    for (int p = 0; p < 8; ++p) {
        a.ph_lo = p; a.ph_hi = p + 1;
        hipLaunchKernelGGL(hymba_fwd, dim3(grid), dim3(512), LDS_BYTES, stream, a);
    }
#endif
}
```

```cpp
#include <hip/hip_runtime.h>
#include <hip/hip_cooperative_groups.h>
#include <cstdio>
#include <cstdint>
#include <cmath>
namespace cg = cooperative_groups;

#ifndef MK_SINGLE
#define MK_SINGLE 1
#endif

constexpr int MG = 16384;
constexpr int NB = 2, T = 8192, NMETA = 16, LP = 8256, MV = 2 * LP  , MR = 16640, DM = 1024, NP = 4096, PW = 4104, TPB = LP / 64  , NT64 = MV / 64  ;
constexpr float LOG2E = 1.4426950408889634f;
constexpr float C2 = 0.125f * LOG2E;
constexpr float NORM_EPS = 1e-6f;

__device__ __forceinline__ bool row_valid(int R) { if (R >= MV) return false; const int pp = R >= LP ? R - LP : R; return pp >= 48; }
__device__ __forceinline__ int row_pos(int R) { const int pp = R >= LP ? R - LP : R; return pp - 48; }
__device__ __forceinline__ float* hrow(float* out, float* hside, int R) {
    if (R >= MV) return hside + (size_t)(128 + R - MV) * DM;
    const int b = R >= LP ? 1 : 0, pp = R - b * LP;
    if (pp < 64) return hside + (size_t)(b * 64 + pp) * DM;
    return out + ((size_t)b * T + (pp - 64)) * DM;
}

namespace pg8 {
#define PG8_LAS __attribute__((address_space(3)))
typedef unsigned short bf16_t;
typedef short bf16x8 __attribute__((ext_vector_type(8)));
typedef float f32x4 __attribute__((ext_vector_type(4)));
typedef unsigned u32x4 __attribute__((ext_vector_type(4)));
constexpr int BM = 256, BK = 64, HALF = 128, HTB = HALF * BK * 2  , STAGE_BYTES = 8 * HTB, NXCD = 8, WGM = 8;

__host__ __device__ __forceinline__ int lds_byte(int r, int c) { const int st = (r >> 4) * 2 + (c >> 5), rr = r & 15, cc = c & 31, ob = rr * 64 + cc * 2; return st * 1024 + (ob ^ (((ob >> 9) & 1) << 5)); }
__host__ __device__ __forceinline__ void stage_rc(int b, int& R, int& C) { const int st = b / 1024, sb = b % 1024, swz = sb ^ (((sb >> 9) & 1) << 5); R = (st >> 1) * 16 + swz / 64; C = (st & 1) * 32 + (swz % 64) / 2; }
__host__ __device__ __forceinline__ int perm32(int rho) { const int n = rho >> 4, i = rho & 15; return 8 * (i >> 2) + 4 * n + (i & 3); }

struct Unit { int pm, pn; };
struct Gemm { const bf16_t* A; const bf16_t* Bt; int M, N, K; };

struct StaticOrder {
    int nM, nN, nwg, G, c;
    __host__ __device__ void init(int M, int N, int G_, int c_) { nM = M / BM; nN = N / BM; nwg = nM * nN; G = G_; c = c_; }
    __host__ __device__ bool next(int i, Unit& u) const {
        const long L = (long)i * G + c; if (L >= nwg) return false;
        int wgid = (int)L; { const int q = nwg / NXCD, r = nwg % NXCD, xcd = wgid % NXCD, off = wgid / NXCD; wgid = (xcd < r ? xcd * (q + 1) : r * (q + 1) + (xcd - r) * q) + off; }
        const int nig = WGM * nN, gid = wgid / nig, fm = gid * WGM, gsz = (nM - fm) < WGM ? (nM - fm) : WGM;
        u.pm = fm + ((wgid % nig) % gsz); u.pn = (wgid % nig) / gsz; return true;
    }
    __device__ __forceinline__ void a_ready(const Unit&) const {}
    __device__ __forceinline__ void done(const Unit&) const {}
};


__device__ __forceinline__ unsigned cvt_pk_bf16(float lo, float hi) { unsigned r; asm volatile("v_cvt_pk_bf16_f32 %0, %1, %2" : "=v"(r) : "v"(lo), "v"(hi)); return r; }
typedef unsigned u32x2 __attribute__((ext_vector_type(2)));
struct EpiIn {
    static constexpr bool PERM = true, AFTER_DRAIN = false;
    bf16_t* P; const float* sumsq; const float* rope; unsigned* nrm;
    __device__ __forceinline__ void operator()(const f32x4 (&acc)[2][2][4][2], const Unit& u, int wr, int wc, int fr, int fq) const {
        const int pn = u.pn;
        const int mode = (pn < 4) ? 1 : ((pn == 6 || pn == 7 || pn >= 14) ? 2 : 0);
        const float sc = (pn < 2 || pn == 8 || pn == 9) ? C2 : 1.f;
        const int colb = pn * 256 + wc * 32 + 8 * fq;
        float mxb[2] = {0.f, 0.f};
#pragma unroll
        for (int ai = 0; ai < 2; ++ai)
#pragma unroll
            for (int m = 0; m < 4; ++m) {
                const int row = u.pm * BM + ai * HALF + wr * 64 + m * 16 + fr;
                const float rs = rsqrtf(sumsq[row] * (1.0f / DM) + NORM_EPS) * sc;
                const int bb = row >> 13, tt = row & 8191; const size_t R = (size_t)bb * LP + 64 + tt; const int pos = 16 + tt;
#pragma unroll
                for (int bj = 0; bj < 2; ++bj) {
                    const int col = colb + bj * HALF;
                    f32x4 v0 = acc[ai][bj][m][0] * rs, v1 = acc[ai][bj][m][1] * rs;
                    if (mode == 1) {
                        const int j0 = (col & 63) >> 1;
                        const f32x4* cs = (const f32x4*)(rope + ((size_t)pos * 32 + j0) * 2);
                        const f32x4 a = cs[0], b = cs[1];
                        f32x4 w0, w1;
                        w0[0] = v0[0] * a[0] - v0[1] * a[1]; w0[1] = v0[1] * a[0] + v0[0] * a[1];
                        w0[2] = v0[2] * a[2] - v0[3] * a[3]; w0[3] = v0[3] * a[2] + v0[2] * a[3];
                        w1[0] = v1[0] * b[0] - v1[1] * b[1]; w1[1] = v1[1] * b[0] + v1[0] * b[1];
                        w1[2] = v1[2] * b[2] - v1[3] * b[3]; w1[3] = v1[3] * b[2] + v1[2] * b[3];
                        v0 = w0; v1 = w1;
                    } else if (mode == 2) {
#pragma unroll
                        for (int i = 0; i < 4; ++i) { v0[i] = v0[i] * __builtin_amdgcn_rcpf(1.f + __builtin_amdgcn_exp2f(-v0[i] * LOG2E)); v1[i] = v1[i] * __builtin_amdgcn_rcpf(1.f + __builtin_amdgcn_exp2f(-v1[i] * LOG2E)); }
                    }
                    u32x4 w; w.x = cvt_pk_bf16(v0[0], v0[1]); w.y = cvt_pk_bf16(v0[2], v0[3]); w.z = cvt_pk_bf16(v1[0], v1[1]); w.w = cvt_pk_bf16(v1[2], v1[3]);
                    *(u32x4*)(P + R * NP + col) = w;
                    if (pn >= 8 && pn < 12) { float ss = (v0[0] * v0[0] + v0[1] * v0[1]) + (v0[2] * v0[2] + v0[3] * v0[3]) + (v1[0] * v1[0] + v1[1] * v1[1]) + (v1[2] * v1[2] + v1[3] * v1[3]);
                        ss += __shfl_xor(ss, 16); ss += __shfl_xor(ss, 32); mxb[bj] = fmaxf(mxb[bj], ss); }
                }
            }
        if (pn >= 8 && pn < 12) {
#pragma unroll
            for (int bj = 0; bj < 2; ++bj) { float mx = mxb[bj];
#pragma unroll
                for (int o = 1; o < 16; o <<= 1) mx = fmaxf(mx, __shfl_xor(mx, o));
                if (fr == 0 && fq == 0) atomicMax(nrm + (((pn >= 10) ? 8 : 0) + (pn & 1) * 4 + bj * 2 + (wc >> 1)) * 2 + (wc & 1), __float_as_uint(mx)); }
        }
    }
};
struct EpiOut {
    static constexpr bool PERM = false, AFTER_DRAIN = false;
    const float* base; float* out; bf16_t* hb; float* sumsq_next; int write_hb;
    __device__ __forceinline__ void operator()(const f32x4 (&acc)[2][2][4][2], const Unit& u, int wr, int wc, int fr, int fq) const {
        const int col0 = u.pn * BM + wc * 32 + 4 * fq;
#pragma unroll
        for (int ai = 0; ai < 2; ++ai)
#pragma unroll
            for (int m = 0; m < 4; ++m) {
                const int row = u.pm * BM + ai * HALF + wr * 64 + m * 16 + fr;
                float* hp = out + (size_t)row * DM; const float* bp = base + (size_t)row * DM;
                float ss = 0.f;
#pragma unroll
                for (int bj = 0; bj < 2; ++bj)
#pragma unroll
                    for (int n = 0; n < 2; ++n) {
                        const int c = col0 + bj * HALF + n * 16;
                        const f32x4 hv = *(const f32x4*)(bp + c);
                        f32x4 o = hv + acc[ai][bj][m][n];
                        *(f32x4*)(hp + c) = o;
                        ss += (o[0] * o[0] + o[1] * o[1]) + (o[2] * o[2] + o[3] * o[3]);
                        if (write_hb) { u32x2 w; w.x = cvt_pk_bf16(o[0], o[1]); w.y = cvt_pk_bf16(o[2], o[3]); *(u32x2*)(hb + (size_t)row * DM + c) = w; }
                    }
                ss += __shfl_xor(ss, 16); ss += __shfl_xor(ss, 32);
                if (fq == 0) atomicAdd(sumsq_next + row, ss);
            }
    }
};
struct EpiOutFinal {
    static constexpr bool PERM = false, AFTER_DRAIN = false;
    const float* base; float* out; float* sumsq; unsigned* cnt; const float* fg;
    __device__ __forceinline__ void operator()(f32x4 (&acc)[2][2][4][2], const Unit& u, int wr, int wc, int fr, int fq) const {
        const int col0 = u.pn * BM + wc * 32 + 4 * fq;
#pragma unroll
        for (int ai = 0; ai < 2; ++ai)
#pragma unroll
            for (int m = 0; m < 4; ++m) {
                const int row = u.pm * BM + ai * HALF + wr * 64 + m * 16 + fr;
                const float* bp = base + (size_t)row * DM;
                float ss = 0.f;
#pragma unroll
                for (int bj = 0; bj < 2; ++bj)
#pragma unroll
                    for (int n = 0; n < 2; ++n) {
                        const f32x4 o = *(const f32x4*)(bp + col0 + bj * HALF + n * 16) + acc[ai][bj][m][n];
                        acc[ai][bj][m][n] = o;
                        ss += (o[0] * o[0] + o[1] * o[1]) + (o[2] * o[2] + o[3] * o[3]);
                    }
                ss += __shfl_xor(ss, 16); ss += __shfl_xor(ss, 32);
                if (fq == 0) atomicAdd(sumsq + row, ss);
            }
        asm volatile("s_waitcnt vmcnt(0)" ::: "memory");
        __syncthreads();
        if (threadIdx.x == 0) {
            __hip_atomic_fetch_add(cnt + u.pm, 1u, __ATOMIC_RELAXED, __HIP_MEMORY_SCOPE_AGENT);
            unsigned spins = 0;
            while (__hip_atomic_load(cnt + u.pm, __ATOMIC_RELAXED, __HIP_MEMORY_SCOPE_AGENT) < 4u && ++spins < (1u << 22)) __builtin_amdgcn_s_sleep(1);
        }
        __syncthreads();
#pragma unroll
        for (int ai = 0; ai < 2; ++ai)
#pragma unroll
            for (int m = 0; m < 4; ++m) {
                const int row = u.pm * BM + ai * HALF + wr * 64 + m * 16 + fr;
                const float ssr = __hip_atomic_load(sumsq + row, __ATOMIC_RELAXED, __HIP_MEMORY_SCOPE_AGENT);
                const float r = rsqrtf(ssr * (1.0f / DM) + NORM_EPS);
#pragma unroll
                for (int bj = 0; bj < 2; ++bj)
#pragma unroll
                    for (int n = 0; n < 2; ++n) {
                        const int c = col0 + bj * HALF + n * 16;
                        const f32x4 g = *(const f32x4*)(fg + c);
                        *(f32x4*)(out + (size_t)row * DM + c) = acc[ai][bj][m][n] * r * g;
                    }
            }
    }
};

template <class Epi, class Sched, bool ALIGN_EPI = false, bool SP2 = false>
__device__ __forceinline__ void gemm_phase(PG8_LAS unsigned char* lds, const Gemm g, const Sched& S, const Epi& E) {
    int tid_ = threadIdx.x; asm volatile("" : "+v"(tid_));
    const int tid = tid_, wid = __builtin_amdgcn_readfirstlane(tid >> 6), lane = tid & 63, wr = wid >> 2, wc = wid & 3, fr = lane & 15, fq = lane >> 4;
    const int K = g.K, nt = K / BK;
    unsigned voffA[2], voffB[2];
#pragma unroll
    for (int i = 0; i < 2; ++i) { int R, C; stage_rc(tid * 16 + i * 8192, R, C); const int Rb = Epi::PERM ? ((R & ~31) + perm32(R & 31)) : R;
        voffA[i] = (unsigned)(R * K + C) * 2u; voffB[i] = (unsigned)(Rb * K + C) * 2u; }
    const size_t kstep = (size_t)(BK * 2);
    const size_t hstep = (size_t)HALF * K * 2;
    const size_t tstep = 2 * hstep;
    const unsigned ldsw = (unsigned)wid * 1024u;
    const int aoff = lds_byte(wr * 64 + fr, fq * 8), boff = lds_byte(wc * 32 + fr, fq * 8);
#define PG8_SA(b, h) (((b) * 2 + (h)) * HTB)
#define PG8_SB(b, h) ((4 + (b) * 2 + (h)) * HTB)
#define PG8_STAGE(bufoff, gbase, voff) do { _Pragma("unroll") for (int _i = 0; _i < 2; ++_i) \
        __builtin_amdgcn_global_load_lds((const unsigned*)((const char*)(gbase) + (voff)[_i]), (PG8_LAS unsigned*)(lds + (bufoff) + ldsw + _i * 8192), 16, 0, 0); } while (0)
#define PG8_LDA(dst, b, h) do { _Pragma("unroll") for (int m = 0; m < 4; ++m) _Pragma("unroll") for (int k = 0; k < 2; ++k) dst[m][k] = *(const PG8_LAS bf16x8*)(lds + PG8_SA(b, h) + aoff + m * 2048 + k * 1024); } while (0)
#define PG8_LDB(dst, b, h) do { _Pragma("unroll") for (int n = 0; n < 2; ++n) _Pragma("unroll") for (int k = 0; k < 2; ++k) dst[n][k] = *(const PG8_LAS bf16x8*)(lds + PG8_SB(b, h) + boff + n * 2048 + k * 1024); } while (0)
#define PG8_MMA(ai, bj, At, Bt) do { __builtin_amdgcn_s_setprio(1); _Pragma("unroll") for (int m = 0; m < 4; ++m) _Pragma("unroll") for (int n = 0; n < 2; ++n) _Pragma("unroll") for (int k = 0; k < 2; ++k) \
        acc[ai][bj][m][n] = __builtin_amdgcn_mfma_f32_16x16x32_bf16(Bt[n][k], At[m][k], acc[ai][bj][m][n], 0, 0, 0); __builtin_amdgcn_s_setprio(0); } while (0)
#define PG8_WAIT_V(n) asm volatile("s_waitcnt vmcnt(" #n ")" ::: "memory")
#define PG8_WAIT_L(n) asm volatile("s_waitcnt lgkmcnt(" #n ")" ::: "memory")
#define PG8_BAR __builtin_amdgcn_s_barrier()
#define PG8_SCHED __builtin_amdgcn_sched_barrier(0)
    Unit cur, nxt; int ui = 0;
    if (!S.next(0, cur)) return;
    f32x4 acc[2][2][4][2];
#pragma unroll
    for (int a = 0; a < 2; ++a)
#pragma unroll
        for (int b = 0; b < 2; ++b)
#pragma unroll
            for (int m = 0; m < 4; ++m)
#pragma unroll
                for (int n = 0; n < 2; ++n) acc[a][b][m][n] = (f32x4){0.f, 0.f, 0.f, 0.f};
    bf16x8 At[4][2], B0[2][2], B1[2][2];
    const char* cA = (const char*)g.A + (size_t)cur.pm * tstep; const char* cB = (const char*)g.Bt + (size_t)cur.pn * tstep;
    S.a_ready(cur);
    if constexpr (SP2) {
        PG8_STAGE(PG8_SB(0, 0), cB, voffB); PG8_STAGE(PG8_SB(0, 1), cB + hstep, voffB); PG8_STAGE(PG8_SA(0, 0), cA, voffA); PG8_STAGE(PG8_SA(0, 1), cA + hstep, voffA);
        if (wr == 1) PG8_BAR;
        PG8_WAIT_V(2); PG8_BAR;
        PG8_STAGE(PG8_SB(1, 0), cB + kstep, voffB); PG8_STAGE(PG8_SA(1, 0), cA + kstep, voffA); PG8_STAGE(PG8_SB(1, 1), cB + hstep + kstep, voffB);
        PG8_WAIT_V(6); PG8_BAR;
    } else {
        PG8_STAGE(PG8_SB(0, 0), cB, voffB); PG8_STAGE(PG8_SA(0, 0), cA, voffA); PG8_STAGE(PG8_SB(0, 1), cB + hstep, voffB); PG8_STAGE(PG8_SA(0, 1), cA + hstep, voffA);
        if (wr == 1) PG8_BAR;
        PG8_WAIT_V(4); PG8_BAR;
        PG8_STAGE(PG8_SB(1, 0), cB + kstep, voffB); PG8_STAGE(PG8_SA(1, 0), cA + kstep, voffA); PG8_STAGE(PG8_SB(1, 1), cB + hstep + kstep, voffB);
        PG8_WAIT_V(6); PG8_BAR;
    }
    for (;;) {
        const bool has_next = S.next(ui + 1, nxt);
        const char* nA = has_next ? (const char*)g.A + (size_t)nxt.pm * tstep : cA; const char* nB = has_next ? (const char*)g.Bt + (size_t)nxt.pn * tstep : cB;
        for (int t = 0; t < nt; t += 2) {
            const bool last = (t == nt - 2);
            const char* a1 = cA + (size_t)(t + 1) * kstep;
            const char* a2 = last ? nA : cA + (size_t)(t + 2) * kstep; const char* b2 = last ? nB : cB + (size_t)(t + 2) * kstep;
            const char* a3 = a2 + kstep; const char* b3 = b2 + kstep;
            if (last && has_next) S.a_ready(nxt);
            if constexpr (SP2) {
            PG8_LDB(B0, 0, 0); PG8_LDB(B1, 0, 1); PG8_SCHED; PG8_LDA(At, 0, 0); PG8_STAGE(PG8_SA(1, 1), a1 + hstep, voffA);
            PG8_WAIT_V(8); PG8_WAIT_L(0); PG8_BAR; PG8_MMA(0, 0, At, B0); PG8_MMA(0, 1, At, B1); PG8_BAR; PG8_SCHED;
            PG8_LDA(At, 0, 1); PG8_STAGE(PG8_SB(0, 0), b2, voffB); PG8_STAGE(PG8_SB(0, 1), b2 + hstep, voffB); PG8_STAGE(PG8_SA(0, 0), a2, voffA);
            PG8_WAIT_V(8); PG8_WAIT_L(0); PG8_BAR; PG8_MMA(1, 0, At, B0); PG8_MMA(1, 1, At, B1); PG8_BAR; PG8_SCHED;
            PG8_LDB(B0, 1, 0); PG8_LDB(B1, 1, 1); PG8_SCHED; PG8_LDA(At, 1, 0); PG8_STAGE(PG8_SA(0, 1), a2 + hstep, voffA);
            PG8_WAIT_V(8); PG8_WAIT_L(0); PG8_BAR; PG8_MMA(0, 0, At, B0); PG8_MMA(0, 1, At, B1); PG8_BAR; PG8_SCHED;
            PG8_LDA(At, 1, 1); PG8_STAGE(PG8_SB(1, 0), b3, voffB); PG8_STAGE(PG8_SB(1, 1), b3 + hstep, voffB); PG8_STAGE(PG8_SA(1, 0), a3, voffA);
            PG8_WAIT_V(8); PG8_WAIT_L(0); PG8_BAR; PG8_MMA(1, 0, At, B0); PG8_MMA(1, 1, At, B1); PG8_BAR; PG8_SCHED;
            } else {
            PG8_LDB(B0, 0, 0); PG8_SCHED; PG8_LDA(At, 0, 0); PG8_STAGE(PG8_SA(1, 1), a1 + hstep, voffA);
            PG8_WAIT_L(8); PG8_BAR; PG8_WAIT_L(0); PG8_MMA(0, 0, At, B0); PG8_BAR; PG8_SCHED;
            PG8_LDB(B1, 0, 1); PG8_STAGE(PG8_SB(0, 0), b2, voffB);
            PG8_BAR; PG8_WAIT_L(0); PG8_MMA(0, 1, At, B1); PG8_BAR;
            PG8_LDA(At, 0, 1); PG8_STAGE(PG8_SA(0, 0), a2, voffA);
            PG8_BAR; PG8_WAIT_L(0); PG8_MMA(1, 0, At, B0); PG8_BAR; PG8_SCHED;
            PG8_STAGE(PG8_SB(0, 1), b2 + hstep, voffB);
            PG8_WAIT_V(6); PG8_BAR; PG8_MMA(1, 1, At, B1); PG8_BAR;
            PG8_LDB(B0, 1, 0); PG8_SCHED; PG8_LDA(At, 1, 0); PG8_STAGE(PG8_SA(0, 1), a2 + hstep, voffA);
            PG8_WAIT_L(8); PG8_BAR; PG8_WAIT_L(0); PG8_MMA(0, 0, At, B0); PG8_BAR; PG8_SCHED;
            PG8_LDB(B1, 1, 1); PG8_STAGE(PG8_SB(1, 0), b3, voffB);
            PG8_BAR; PG8_WAIT_L(0); PG8_MMA(0, 1, At, B1); PG8_BAR;
            PG8_LDA(At, 1, 1); PG8_STAGE(PG8_SA(1, 0), a3, voffA);
            PG8_BAR; PG8_WAIT_L(0); PG8_MMA(1, 0, At, B0); PG8_BAR; PG8_SCHED;
            PG8_STAGE(PG8_SB(1, 1), b3 + hstep, voffB);
            PG8_WAIT_V(6); PG8_BAR; PG8_MMA(1, 1, At, B1); PG8_BAR;
            }
        }
        if constexpr (ALIGN_EPI) { if (wr == 0) PG8_BAR; }
        if constexpr (!Epi::AFTER_DRAIN) { E(acc, cur, wr, wc, fr, fq); S.done(cur); }
        if (!has_next) break;
#pragma unroll
        for (int a = 0; a < 2; ++a)
#pragma unroll
            for (int b = 0; b < 2; ++b)
#pragma unroll
                for (int m = 0; m < 4; ++m)
#pragma unroll
                    for (int n = 0; n < 2; ++n) acc[a][b][m][n] = (f32x4){0.f, 0.f, 0.f, 0.f};
        cur = nxt; cA = nA; cB = nB; ++ui;
        if constexpr (ALIGN_EPI) { if (wr == 1) PG8_BAR; }
    }
    PG8_WAIT_V(0);
    if constexpr (!ALIGN_EPI) { if (wr == 0) PG8_BAR; }
    PG8_BAR;
    if constexpr (Epi::AFTER_DRAIN) { E.fused(acc, cur, wr, wc, fr, fq, lds, wid, lane); S.done(cur); }
#undef PG8_SA
#undef PG8_SB
#undef PG8_STAGE
#undef PG8_LDA
#undef PG8_LDB
#undef PG8_MMA
#undef PG8_WAIT_V
#undef PG8_WAIT_L
#undef PG8_BAR
#undef PG8_SCHED
}
}

#define LAS __attribute__((address_space(3)))
typedef LAS unsigned char* ldsp;
typedef unsigned short bf16;
typedef short bf16x8 __attribute__((ext_vector_type(8)));
typedef short s16x4 __attribute__((ext_vector_type(4)));
typedef float f32x16 __attribute__((ext_vector_type(16)));
typedef float f32x4 __attribute__((ext_vector_type(4)));
typedef float f32x2 __attribute__((ext_vector_type(2)));
typedef unsigned u32x4 __attribute__((ext_vector_type(4)));
typedef unsigned u32x2 __attribute__((ext_vector_type(2)));
typedef __bf16 bf16x2_t __attribute__((ext_vector_type(2)));
__device__ __forceinline__ unsigned cvtpk(float lo, float hi) { f32x2 v = {lo, hi}; bf16x2_t b = __builtin_convertvector(v, bf16x2_t); return __builtin_bit_cast(unsigned, b); }
__device__ __forceinline__ float bf_lo(unsigned u) { return __uint_as_float(u << 16); }
__device__ __forceinline__ float bf_hi(unsigned u) { return __uint_as_float(u & 0xffff0000u); }
__device__ __forceinline__ float swap32_max(float m) { auto rr = __builtin_amdgcn_permlane32_swap(__float_as_uint(m), __float_as_uint(m), false, false); return fmaxf(__uint_as_float(rr[0]), __uint_as_float(rr[1])); }
__device__ __forceinline__ float swap32_sum(float m) { auto rr = __builtin_amdgcn_permlane32_swap(__float_as_uint(m), __float_as_uint(m), false, false); return __uint_as_float(rr[0]) + __uint_as_float(rr[1]); }
__device__ __forceinline__ int crow(int r, int hi) { return (r & 3) + 8 * (r >> 2) + 4 * hi; }
typedef short v4i16_t __attribute__((ext_vector_type(4)));
__device__ __forceinline__ s16x4 vtr(ldsp p) { return __builtin_bit_cast(s16x4, __builtin_amdgcn_ds_read_tr16_b64_v4i16((LAS v4i16_t*)p)); }
__device__ __forceinline__ float wave_sum(float v) {
#pragma unroll
    for (int o = 1; o < 64; o <<= 1) v += __shfl_xor(v, o);
    return v;
}

constexpr size_t MiB = 1u << 20;
constexpr size_t WS_CTL = 0;
constexpr size_t WS_LAM = 4096;
constexpr size_t WS_UNITS = 8192;
constexpr size_t WS_BAR = 32 * 1024;
constexpr size_t WS_SUMSQ = 64 * 1024;
constexpr size_t WS_CUMTOT = 512 * 1024;
constexpr size_t WS_CUMLOC = 1 * MiB;
constexpr size_t WS_HSIDE = 2 * MiB;
constexpr size_t WS_ROPE = 3 * MiB;
constexpr size_t WS_WIN = 6 * MiB;
constexpr size_t WS_WOUT = 22 * MiB;
constexpr size_t WS_HB = 26 * MiB;
constexpr size_t WS_MIX = 59 * MiB;
constexpr size_t WS_P = 92 * MiB;
constexpr size_t WS_END = 223 * MiB;
static_assert(WS_HB + (size_t)MR * DM * 2 <= WS_MIX && WS_MIX + (size_t)MR * DM * 2 <= WS_P && WS_P + (size_t)MR * NP * 2 <= WS_END, "ws map");
constexpr int N_DIFF_UNITS = 8 * 65, N_FOX_UNITS = 16 * 33, N_UNITS = N_DIFF_UNITS + N_FOX_UNITS;

constexpr int LDS_BYTES = 147456;
constexpr int LDS_PREF = 132 * 1024, LDS_MISC = 133 * 1024;

struct Frame {
    const float *x, *meta, *norm_g, *w_in, *b_forget, *lq1, *lk1, *lq2, *lk2, *subln_g, *w_out, *final_g;
    float* out; unsigned char* ws;
    unsigned* ctl; float* lam; int* units; float* sumsq; float* cumtot; float* cumloc; float* hside; float* rope;
    bf16 *win_t, *wout_t, *hb, *mix, *P, *mixm;
    ldsp lds; int tid, lane, wave, G, bid;
};

__device__ __forceinline__ unsigned f2bf(float f) { unsigned u = __float_as_uint(f); return (u + 0x7fffu + ((u >> 16) & 1u)) >> 16; }
__device__ __forceinline__ unsigned pk2(float lo, float hi) { return f2bf(lo) | (f2bf(hi) << 16); }
__device__ __forceinline__ void transpose_item(const float* W, int ldw, bool ropemap, const float* g, bf16* WT, int nN, LAS float* scr, int item, int lane) {
    const int nblk = nN / 32, kb = item / nblk, nb = item % nblk, k0 = 64 * kb, n0 = 32 * nb;
    const int n = n0 + (lane & 31);
    int col = n; if (ropemap && n < 1024) { const int p = n & 63; col = (n & ~63) + (p >> 1) + 32 * (p & 1); }
    float wv_[32];
#pragma unroll
    for (int i = 0; i < 32; ++i) { const int kk = 2 * i + (lane >> 5); wv_[i] = W[(size_t)(k0 + kk) * ldw + col]; }
#pragma unroll
    for (int i = 0; i < 32; ++i) { const int kk = 2 * i + (lane >> 5); const float gv = g ? g[k0 + kk] : 1.f; scr[kk * 33 + (lane & 31)] = wv_[i] * gv; }
    asm volatile("s_waitcnt lgkmcnt(0)" ::: "memory");
    const int c = lane & 7;
#pragma unroll
    for (int j = 0; j < 4; ++j) { const int nn = (lane >> 3) + 8 * j; const LAS float* s = scr + (8 * c) * 33 + nn;
        u32x4 o; o.x = pk2(s[0 * 33], s[1 * 33]); o.y = pk2(s[2 * 33], s[3 * 33]); o.z = pk2(s[4 * 33], s[5 * 33]); o.w = pk2(s[6 * 33], s[7 * 33]);
        *(u32x4*)(WT + (size_t)(n0 + nn) * DM + k0 + 8 * c) = o; }
    asm volatile("s_waitcnt lgkmcnt(0)" ::: "memory");
}
__device__ __forceinline__ int unit_cost(int u, const float* bfg) {
    if (u < N_DIFF_UNITS) { const int qi = u % 65; return (qi == 0 ? 1 : 1 + 2 * qi) * 4; }
    const int v = u - N_DIFF_UNITS, qi = v % 33, h = (v / 33) & 7;
    const float rate = 1.44f * 1.65f * log1pf(expf(-bfg[h]));
    const int wt = 6 + (int)(95.0f / (64.0f * rate));
    const int full = (qi == 0 ? 1 : 1 + 4 * qi);
    return (full < wt ? full : wt) * 3;
}
__device__ __forceinline__ void p0_prologue(Frame& F) {
    const int gw = F.bid * 8 + F.wave, NGW = F.G * 8, gt = F.bid * 512 + F.tid, NGT = F.G * 512;
    LAS float* scr = (LAS float*)(F.lds + F.wave * 16384);
    constexpr int I_IN = 16 * (NP / 32), I_OUT = 16 * (DM / 32);
    for (int it = gw; it < 2 * (I_IN + I_OUT); it += NGW) {
        int r = it; const int l = r / (I_IN + I_OUT); r -= l * (I_IN + I_OUT);
        if (r < I_IN) transpose_item(F.w_in + (size_t)l * DM * PW, PW, true, F.norm_g + l * DM, F.win_t + (size_t)l * NP * DM, NP, scr, r, F.lane);
        else transpose_item(F.w_out + (size_t)l * DM * DM, DM, false, nullptr, F.wout_t + (size_t)l * DM * DM, DM, scr, r - I_IN, F.lane);
    }
    for (int m0 = gw * 4; m0 < MG; m0 += NGW * 4) {
        f32x4 v[4][4];
#pragma unroll
        for (int q = 0; q < 4; ++q)
#pragma unroll
            for (int j = 0; j < 4; ++j) v[q][j] = *(const f32x4*)(F.x + (size_t)(m0 + q) * DM + 4 * F.lane + 256 * j);
#pragma unroll
        for (int q = 0; q < 4; ++q) {
            const int m = m0 + q; float ss = 0.f;
#pragma unroll
            for (int j = 0; j < 4; ++j) {
                u32x2 w; w.x = pk2(v[q][j][0], v[q][j][1]); w.y = pk2(v[q][j][2], v[q][j][3]);
                *(u32x2*)(F.hb + (size_t)m * DM + 4 * F.lane + 256 * j) = w;
                ss += (v[q][j][0] * v[q][j][0] + v[q][j][1] * v[q][j][1]) + (v[q][j][2] * v[q][j][2] + v[q][j][3] * v[q][j][3]);
            }
            ss = wave_sum(ss);
            if (F.lane == 0) { F.sumsq[m] = ss; F.sumsq[MG + m] = 0.f; F.sumsq[2 * MG + m] = 0.f; }
        }
    }
    for (int i = gt; i < NMETA * DM; i += NGT) F.hside[i] = F.meta[i];
    for (int i = gt; i < 2 * 48 * (NP / 8); i += NGT) { const int rr = i / (NP / 8), c8 = i % (NP / 8); const int R = (rr / 48) * LP + (rr % 48);
        *(u32x4*)(F.P + (size_t)R * NP + c8 * 8) = (u32x4){0u, 0u, 0u, 0u}; }
    for (int i = gt; i < 8208 * 32; i += NGT) {
        const int pos = i >> 5, j = i & 31;
        const double inv = exp2(-(double)j * (13.287712379549449 / 32.0));
        const double ang = (double)pos * inv;
        double s, c; sincos(ang, &s, &c);
        F.rope[2 * i] = (float)c; F.rope[2 * i + 1] = (float)s;
    }
    if (F.bid == 0) {
        F.ctl[F.tid] = 0u;
        if (F.tid < 2) {
            const int l = F.tid; float s1 = 0.f, s2 = 0.f;
            for (int i = 0; i < 64; ++i) { s1 += F.lq1[l * 64 + i] * F.lk1[l * 64 + i]; s2 += F.lq2[l * 64 + i] * F.lk2[l * 64 + i]; }
            const float li = 0.8f - 0.6f * expf(-0.3f * (float)l);
            F.lam[l] = expf(s1) - expf(s2) + li;
        }
    }
    for (int ul = gw; ul < 2 * N_UNITS; ul += NGW) {
        const int l = ul / N_UNITS, u = ul - l * N_UNITS; const float* bfg = F.b_forget + l * 8;
        const int cu = unit_cost(u, bfg); int cnt = 0;
        for (int v = F.lane; v < N_UNITS; v += 64) { const int cv = unit_cost(v, bfg); cnt += (cv > cu || (cv == cu && v < u)) ? 1 : 0; }
#pragma unroll
        for (int o = 1; o < 64; o <<= 1) cnt += __shfl_xor(cnt, o);
        if (F.lane == 0) F.units[l * N_UNITS + cnt] = u;
    }
}

__device__ __forceinline__ void forget_item(Frame& F, int layer, int tile) {
    const float* W = F.w_in + (size_t)layer * DM * PW + 4096; const float* g = F.norm_g + layer * DM; const float* bfg = F.b_forget + layer * 8;
    ldsp wl = F.lds;
    LAS float* lf = (LAS float*)(F.lds + 40960);
#pragma unroll
    for (int q = 0; q < 2; ++q) { const int kk = F.tid + 512 * q; const float gv = g[kk];
        const f32x4 a = *(const f32x4*)(W + (size_t)kk * PW) * gv, b = *(const f32x4*)(W + (size_t)kk * PW + 4) * gv;
        *(LAS f32x4*)(wl + (kk >> 2) * 144 + (kk & 3) * 32) = a; *(LAS f32x4*)(wl + (kk >> 2) * 144 + (kk & 3) * 32 + 16) = b; }
    __syncthreads();
    const int row_l = F.tid >> 3, kp = F.tid & 7;
    const int fb = tile >> 7, fj = tile & 127; const size_t R0 = (size_t)fb * LP + 64 + 64 * fj;
    const float* xp = (layer == 0 ? F.x : (const float*)F.out) + ((size_t)tile * 64 + row_l) * DM;
    float acc[8] = {0.f, 0.f, 0.f, 0.f, 0.f, 0.f, 0.f, 0.f}; float ss = 0.f;
#pragma unroll 1
    for (int bt = 0; bt < 4; ++bt) {
        f32x4 xv[8];
#pragma unroll
        for (int i = 0; i < 8; ++i) xv[i] = *(const f32x4*)(xp + 4 * (kp + 8 * (bt * 8 + i)));
#pragma unroll
        for (int i = 0; i < 8; ++i) { ldsp wg = wl + (kp + 8 * (bt * 8 + i)) * 144;
#pragma unroll
            for (int e = 0; e < 4; ++e) { const float xe = xv[i][e]; ss += xe * xe;
                const f32x4 wa = *(LAS f32x4*)(wg + e * 32), wb = *(LAS f32x4*)(wg + e * 32 + 16);
                acc[0] += xe * wa[0]; acc[1] += xe * wa[1]; acc[2] += xe * wa[2]; acc[3] += xe * wa[3];
                acc[4] += xe * wb[0]; acc[5] += xe * wb[1]; acc[6] += xe * wb[2]; acc[7] += xe * wb[3]; } }
    }
#pragma unroll
    for (int o = 1; o < 8; o <<= 1) { ss += __shfl_xor(ss, o);
#pragma unroll
        for (int j = 0; j < 8; ++j) acc[j] += __shfl_xor(acc[j], o); }
    float mine = acc[0];
#pragma unroll
    for (int j = 1; j < 8; ++j) mine = (kp == j) ? acc[j] : mine;
    {
        const float xl = mine * rsqrtf(ss * (1.0f / DM) + NORM_EPS) + bfg[kp];
        float v = fminf(xl, 0.f) - log1pf(expf(-fabsf(xl)));
        lf[row_l * 8 + kp] = v;
    }
    __syncthreads();
    if (F.wave == 0) {
        const int seg = F.lane >> 3, j = F.lane & 7;
        float vals[8]; float run = 0.f;
#pragma unroll
        for (int i = 0; i < 8; ++i) { run += lf[(seg * 8 + i) * 8 + j]; vals[i] = run; }
        float inc = run;
#pragma unroll
        for (int o = 8; o < 64; o <<= 1) { const float t_ = __shfl_up(inc, o); if (F.lane >= o) inc += t_; }
        const float excl = inc - run;
#pragma unroll
        for (int i = 0; i < 8; ++i) F.cumloc[(R0 + seg * 8 + i) * 8 + j] = (excl + vals[i]) * LOG2E;
        if (seg == 7) F.cumtot[(fb * TPB + 1 + fj) * 8 + j] = inc * LOG2E;
    }
    __syncthreads();
}

template <int MODE>
__device__ __forceinline__ void meta_item(Frame& F, int layer, int item) {
    LAS float* xT = (LAS float*)(F.lds);
    LAS float* red = (LAS float*)(F.lds + 65536);
    LAS float* rr = (LAS float*)(F.lds + 98304);
    LAS float* lfm = (LAS float*)(F.lds + 98304 + 256);
    const float* W = MODE == 0 ? F.w_in + (size_t)layer * DM * PW : F.w_out + (size_t)layer * DM * DM;
    const int ldw = MODE == 0 ? PW : DM;
    const float* g = F.norm_g + layer * DM;
    for (int idx = F.tid; idx < NMETA * DM; idx += 512) { const int row = idx >> 10, k = idx & 1023;
        float v; if (MODE == 0) v = F.hside[idx]; else v = __uint_as_float((unsigned)F.mixm[idx] << 16);
        xT[k * 16 + row] = v; }
    __syncthreads();
    if (MODE == 0) {
        const int row = F.tid >> 5, l32 = F.tid & 31; float ss = 0.f;
#pragma unroll 8
        for (int i = 0; i < 32; ++i) { const float v = xT[(l32 + 32 * i) * 16 + row]; ss += v * v; }
#pragma unroll
        for (int o = 1; o < 32; o <<= 1) ss += __shfl_xor(ss, o);
        if (l32 == 0) rr[row] = rsqrtf(ss * (1.0f / DM) + NORM_EPS);
    }
    const int c = F.tid & 15, ks = F.tid >> 4;
    const int n = item * 16 + c;
    int col = n; bool colok = true;
    if (MODE == 0) { if (n < 1024) { const int p = n & 63; col = (n & ~63) + (p >> 1) + 32 * (p & 1); } colok = n < PW; if (!colok) col = 0; }
    float acc[16];
#pragma unroll
    for (int r = 0; r < 16; ++r) acc[r] = 0.f;
#pragma unroll 1
    for (int k8 = 0; k8 < 4; ++k8) {
        float wv[8];
#pragma unroll
        for (int i = 0; i < 8; ++i) { const int k = ks * 32 + k8 * 8 + i; wv[i] = W[(size_t)k * ldw + col] * (MODE == 0 ? g[k] : 1.f); }
#pragma unroll
        for (int i = 0; i < 8; ++i) { const int k = ks * 32 + k8 * 8 + i;
#pragma unroll
            for (int q = 0; q < 4; ++q) { const f32x4 xv = *(LAS f32x4*)(xT + k * 16 + 4 * q);
                acc[4 * q] += wv[i] * xv[0]; acc[4 * q + 1] += wv[i] * xv[1]; acc[4 * q + 2] += wv[i] * xv[2]; acc[4 * q + 3] += wv[i] * xv[3]; } }
    }
#pragma unroll
    for (int r = 0; r < 16; ++r) red[(ks * 16 + r) * 16 + c] = colok ? acc[r] : 0.f;
    __syncthreads();
    if (F.tid < 256) {
        const int r = F.tid >> 4;
        float v = 0.f;
#pragma unroll 8
        for (int s_ = 0; s_ < 32; ++s_) v += red[(s_ * 16 + r) * 16 + c];
        if (MODE == 1) { F.hside[r * DM + n] += v; }
        else {
            v *= rr[r];
            if (item < 256) {
                const int pn = n >> 8;
                const int mode = (pn < 4) ? 1 : ((pn == 6 || pn == 7 || pn >= 14) ? 2 : 0);
                if (pn < 2 || pn == 8 || pn == 9) v *= C2;
                const float partner = __shfl_xor(v, 1);
                if (mode == 1) { const int j = (n & 63) >> 1; const float cs = F.rope[(r * 32 + j) * 2], sn = F.rope[(r * 32 + j) * 2 + 1];
                    v = (n & 1) ? (v * cs + partner * sn) : (v * cs - partner * sn); }
                else if (mode == 2) v = v * __builtin_amdgcn_rcpf(1.f + __builtin_amdgcn_exp2f(-v * LOG2E));
                const bf16 o = (bf16)f2bf(v);
                F.P[((size_t)48 + r) * NP + n] = o; F.P[((size_t)LP + 48 + r) * NP + n] = o;
                if (pn == 10 || pn == 11) {
                    float ss = v * v;
#pragma unroll
                    for (int o2 = 1; o2 < 16; o2 <<= 1) ss += __shfl_xor(ss, o2);
                    if (c == 0) atomicMax(F.ctl + 128 + layer * 128 + 32 + ((n - 2560) >> 4), __float_as_uint(ss));
                }
            } else if (c < 8) {
                const float xl = v + F.b_forget[layer * 8 + c];
                lfm[r * 8 + c] = fminf(xl, 0.f) - log1pf(expf(-fabsf(xl)));
            }
        }
    }
    __syncthreads();
    if (MODE == 0 && item == 256 && F.tid < 8) {
        float run = 0.f;
        for (int pp = 0; pp < 64; ++pp) { if (pp >= 48) run += lfm[(pp - 48) * 8 + F.tid];
            F.cumloc[(size_t)pp * 8 + F.tid] = run * LOG2E; F.cumloc[((size_t)LP + pp) * 8 + F.tid] = run * LOG2E; }
        F.cumtot[F.tid] = run * LOG2E; F.cumtot[TPB * 8 + F.tid] = run * LOG2E;
    }
    __syncthreads();
}

__device__ __forceinline__ void split3(float x, unsigned& h, unsigned& m, unsigned& l) {
    h = cvtpk(x, 0.f) & 0xffffu; const float r1 = x - __uint_as_float(h << 16);
    m = cvtpk(r1, 0.f) & 0xffffu; const float r2 = r1 - __uint_as_float(m << 16);
    l = cvtpk(r2, 0.f) & 0xffffu;
}
struct AttnP { const bf16* P; bf16* mixed; const float* cumloc; const float* cumtot; const float* subg; const unsigned* nrm; bf16* mixm; float lam; float one_m_li; };

template <bool DIFF>
__device__ __forceinline__ void attn_unit(const AttnP& A, int b, int h, int qi, ldsp lds) {
    constexpr int DV = DIFF ? 128 : 64, NTD = DV / 32, KP = DIFF ? 272 : 144, VP = DIFF ? 320 : 192, QROWS = DIFF ? 128 : 256, TPQ = QROWS / 64;
    constexpr int STAGE = 64 * KP + 64 * VP + 256, NPIECE = DIFF ? 2 : 1;
    int tid_ = threadIdx.x; asm volatile("" : "+v"(tid_));
    const int tid = tid_, lane = tid & 63, w = __builtin_amdgcn_readfirstlane(tid >> 6), r32 = lane & 31, hi = lane >> 5;
    const int comp = DIFF ? (w >> 2) : 0, wq = DIFF ? (w & 3) : w;
    const int qstart = qi == 0 ? 0 : 64 + QROWS * (qi - 1);
    const int nt = qi == 0 ? 1 : 1 + TPQ * qi;
    const int diag0 = qi == 0 ? 0 : nt - TPQ;
    const int q_pp = qstart + 32 * wq + r32, qmax_w = qstart + 32 * wq + 31;
    const bool store_ok = (qi != 0) || (b == 0 && q_pp >= 48 && q_pp < 64);
    const size_t Rb = (size_t)b * LP;
    const int qcol = DIFF ? h * 128 + comp * 64 : 2048 + h * 64;
    const int kcol = DIFF ? 512 + h * 128 : 2560 + h * 64;
    const int vcol = DIFF ? 1024 + h * 128 : 3072 + h * 64;
    const int zcol = DIFF ? 1536 + h * 128 : 3584 + h * 64;
    const int mcol = DIFF ? h * 128 : 512 + h * 64;
    const bf16* Pq = A.P + (Rb + q_pp) * NP;
    bf16x8 qf[4];
#pragma unroll
    for (int c = 0; c < 4; ++c) qf[c] = *(const bf16x8*)(Pq + qcol + 16 * c + 8 * hi);
    LAS float* pref = (LAS float*)(lds + LDS_PREF);
    u32x4 kreg[NPIECE], vreg[NPIECE]; float clreg = 0.f;
#define LOAD_TILE(kt) do { const bf16* base_ = A.P + (Rb + 64 * (size_t)(kt)) * NP; \
        _Pragma("unroll") for (int i_ = 0; i_ < NPIECE; ++i_) { const int p_ = tid + 512 * i_; const int row_ = DIFF ? (p_ >> 4) : (p_ >> 3); const int c16_ = DIFF ? (p_ & 15) : (p_ & 7); \
            kreg[i_] = *(const u32x4*)(base_ + (size_t)row_ * NP + kcol + c16_ * 8); vreg[i_] = *(const u32x4*)(base_ + (size_t)row_ * NP + vcol + c16_ * 8); } \
        if (!DIFF && tid < 64) clreg = A.cumloc[(Rb + 64 * (size_t)(kt) + tid) * 8 + h]; } while (0)
#define STORE_TILE(st) do { ldsp sb_ = lds + (st) * STAGE; \
        _Pragma("unroll") for (int i_ = 0; i_ < NPIECE; ++i_) { const int p_ = tid + 512 * i_; const int row_ = DIFF ? (p_ >> 4) : (p_ >> 3); const int c16_ = DIFF ? (p_ & 15) : (p_ & 7); \
            *(LAS u32x4*)(sb_ + row_ * KP + c16_ * 16) = kreg[i_]; *(LAS u32x4*)(sb_ + 64 * KP + row_ * VP + c16_ * 16) = vreg[i_]; } \
        if (!DIFF && tid < 64) { unsigned h_, m_, l_; split3(-clreg, h_, m_, l_); *(LAS u32x4*)(sb_ + tid * KP + 128) = (u32x4){h_ | (m_ << 16), l_ | 0x3f800000u, 0x3f803f80u, 0u}; } } while (0)
    int kt0 = 0;
    if (!DIFF) {
        LAS int* kst = (LAS int*)(lds + LDS_MISC + 64);
        if (tid == 0) *kst = nt - 1;
        if (w == 0) {
            float carry = 0.f;
#pragma unroll
            for (int ch = 0; ch < 3; ++ch) {
                const int idx = ch * 64 + lane;
                const float v = idx < TPB ? A.cumtot[(b * TPB + idx) * 8 + h] : 0.f;
                float inc = v;
#pragma unroll
                for (int o = 1; o < 64; o <<= 1) { const float t_ = __shfl_up(inc, o); if (lane >= o) inc += t_; }
                if (idx < TPB) pref[idx] = carry + inc - v;
                if (idx == TPB - 1) pref[TPB] = carry + inc;
                carry += __shfl(inc, 63);
            }
        }
        __syncthreads();
        const float q2 = __uint_as_float(A.nrm[(h) * 2]) + __uint_as_float(A.nrm[(h) * 2 + 1]), k2r = __uint_as_float(A.nrm[(8 + h) * 2]) + __uint_as_float(A.nrm[(8 + h) * 2 + 1]),
                    k2m = (__uint_as_float(A.nrm[32 + h * 4]) + __uint_as_float(A.nrm[32 + h * 4 + 1])) + (__uint_as_float(A.nrm[32 + h * 4 + 2]) + __uint_as_float(A.nrm[32 + h * 4 + 3])), k2 = fmaxf(k2r, k2m);
        const float thr = 2.0f * 1.03f * sqrtf(q2 * k2) + 40.0f;
        if (tid < nt) { if (pref[qstart >> 6] - pref[tid + 1] >= -thr) atomicMin((int*)kst, tid); }
        __syncthreads();
        kt0 = *kst;
    }
    LOAD_TILE(kt0);
    STORE_TILE(kt0 & 1);
    __syncthreads();
    float cq = 0.f;
    if (!DIFF) cq = pref[q_pp >> 6] + A.cumloc[(Rb + q_pp) * 8 + h];
    float mhat = 0.f, l_run = 0.f;
    f32x16 negm;
#pragma unroll
    for (int r = 0; r < 16; ++r) negm[r] = 0.f;
    f32x16 o[NTD];
#pragma unroll
    for (int t = 0; t < NTD; ++t)
#pragma unroll
        for (int r = 0; r < 16; ++r) o[t][r] = 0.f;
    const int trb = (4 * hi + ((lane & 15) >> 2)) * VP + ((lane >> 4) & 1) * 32 + (lane & 3) * 8;
    for (int kt = kt0; kt < nt; ++kt) {
        if (kt + 1 < nt) LOAD_TILE(kt + 1);
        if (64 * kt <= qmax_w) {
            ldsp Kb = lds + (kt & 1) * STAGE; ldsp Vb = Kb + 64 * KP;
            bf16x8 kf[8];
#pragma unroll
            for (int c = 0; c < 4; ++c) {
                kf[2 * c] = *(LAS bf16x8*)(Kb + r32 * KP + comp * 128 + c * 32 + hi * 16);
                kf[2 * c + 1] = *(LAS bf16x8*)(Kb + (32 + r32) * KP + comp * 128 + c * 32 + hi * 16);
            }
            __builtin_amdgcn_sched_barrier(0);
            f32x16 s0 = negm, s1 = negm;
            bf16x8 ka0, ka1, qa;
            if (!DIFF) {
                ka0 = *(LAS bf16x8*)(Kb + r32 * KP + 128); ka1 = *(LAS bf16x8*)(Kb + (32 + r32) * KP + 128);
                unsigned h_, m_, l_; split3(cq - pref[kt], h_, m_, l_);
                u32x4 qa_ = (u32x4){0x3f803f80u, 0x3f80u | (h_ << 16), m_ | (l_ << 16), 0u};
                if (hi) qa_ = (u32x4){0u, 0u, 0u, 0u};
                qa = __builtin_bit_cast(bf16x8, qa_);
            }
            __builtin_amdgcn_s_setprio(1);
            if (!DIFF) { s0 = __builtin_amdgcn_mfma_f32_32x32x16_bf16(ka0, qa, s0, 0, 0, 0); s1 = __builtin_amdgcn_mfma_f32_32x32x16_bf16(ka1, qa, s1, 0, 0, 0); }
#pragma unroll
            for (int c = 0; c < 4; ++c) {
                s0 = __builtin_amdgcn_mfma_f32_32x32x16_bf16(kf[2 * c], qf[c], s0, 0, 0, 0);
                s1 = __builtin_amdgcn_mfma_f32_32x32x16_bf16(kf[2 * c + 1], qf[c], s1, 0, 0, 0);
            }
            __builtin_amdgcn_s_setprio(0);
            s16x4 vlo[8], vhi[8];
#pragma unroll
            for (int t = 0; t < 2; ++t)
#pragma unroll
                for (int j = 0; j < 4; ++j) { vlo[t * 4 + j] = vtr(Vb + trb + (16 * j) * VP + t * 64); vhi[t * 4 + j] = vtr(Vb + trb + (16 * j + 8) * VP + t * 64); }
            __builtin_amdgcn_sched_barrier(0);
            if (kt == 0 || kt >= diag0) {
#pragma unroll
                for (int r = 0; r < 16; ++r) { const int kpp = 64 * kt + crow(r, hi);
                    if (kpp < 48 || kpp > q_pp) s0[r] = -INFINITY;
                    if (kpp + 32 < 48 || kpp + 32 > q_pp) s1[r] = -INFINITY; }
            }
            float ma = fmaxf(fmaxf(s0[0], s0[1]), s1[0]), mb = fmaxf(fmaxf(s0[2], s0[3]), s1[1]);
            ma = fmaxf(fmaxf(ma, s1[2]), s1[3]);
#pragma unroll
            for (int r = 4; r < 16; r += 4) { ma = fmaxf(fmaxf(ma, s0[r]), s0[r + 1]); mb = fmaxf(fmaxf(mb, s0[r + 2]), s0[r + 3]); ma = fmaxf(fmaxf(ma, s1[r]), s1[r + 1]); mb = fmaxf(fmaxf(mb, s1[r + 2]), s1[r + 3]); }
            const float rm = swap32_max(fmaxf(ma, mb));
            if (kt == kt0 || __any(rm > 24.0f)) {
                const float dl = (kt == kt0) ? ((rm == -INFINITY) ? 0.f : rm) : fmaxf(rm, 0.f);
                mhat += dl;
#pragma unroll
                for (int r = 0; r < 16; ++r) { s0[r] -= dl; s1[r] -= dl; negm[r] = -mhat; }
                const float f = (kt == kt0) ? 1.0f : __builtin_amdgcn_exp2f(-dl);
                l_run *= f;
#pragma unroll
                for (int t = 0; t < NTD; ++t)
#pragma unroll
                    for (int r = 0; r < 16; ++r) o[t][r] *= f;
            }
            float psa = 0.f, psb = 0.f;
#pragma unroll
            for (int r = 0; r < 16; ++r) { s0[r] = __builtin_amdgcn_exp2f(s0[r]); s1[r] = __builtin_amdgcn_exp2f(s1[r]); psa += s0[r]; asm("" : "+v"(psa)); psb += s1[r]; asm("" : "+v"(psb)); }
            l_run += psa + psb;
            bf16x8 pw[4];
#pragma unroll
            for (int j = 0; j < 4; ++j) {
                u32x4 pk;
                if (j < 2) { const int rb = 8 * (j & 1); pk.x = cvtpk(s0[rb], s0[rb + 1]); pk.y = cvtpk(s0[rb + 2], s0[rb + 3]); pk.z = cvtpk(s0[rb + 4], s0[rb + 5]); pk.w = cvtpk(s0[rb + 6], s0[rb + 7]); }
                else { const int rb = 8 * (j & 1); pk.x = cvtpk(s1[rb], s1[rb + 1]); pk.y = cvtpk(s1[rb + 2], s1[rb + 3]); pk.z = cvtpk(s1[rb + 4], s1[rb + 5]); pk.w = cvtpk(s1[rb + 6], s1[rb + 7]); }
                pw[j] = __builtin_bit_cast(bf16x8, pk);
            }
            __builtin_amdgcn_sched_barrier(0);
            __builtin_amdgcn_s_setprio(1);
#pragma unroll
            for (int t = 0; t < 2; ++t)
#pragma unroll
                for (int j = 0; j < 4; ++j) {
                    const bf16x8 vf = (bf16x8){vlo[t * 4 + j][0], vlo[t * 4 + j][1], vlo[t * 4 + j][2], vlo[t * 4 + j][3], vhi[t * 4 + j][0], vhi[t * 4 + j][1], vhi[t * 4 + j][2], vhi[t * 4 + j][3]};
                    o[t] = __builtin_amdgcn_mfma_f32_32x32x16_bf16(vf, pw[j], o[t], 0, 0, 0);
                }
            if (DIFF) {
#pragma unroll
                for (int t = 2; t < NTD; ++t)
#pragma unroll
                    for (int j = 0; j < 4; ++j) { vlo[(t - 2) * 4 + j] = vtr(Vb + trb + (16 * j) * VP + t * 64); vhi[(t - 2) * 4 + j] = vtr(Vb + trb + (16 * j + 8) * VP + t * 64); }
                __builtin_amdgcn_sched_barrier(0);
#pragma unroll
                for (int t = 2; t < NTD; ++t)
#pragma unroll
                    for (int j = 0; j < 4; ++j) {
                        const int i = (t - 2) * 4 + j;
                        const bf16x8 vf = (bf16x8){vlo[i][0], vlo[i][1], vlo[i][2], vlo[i][3], vhi[i][0], vhi[i][1], vhi[i][2], vhi[i][3]};
                        o[t] = __builtin_amdgcn_mfma_f32_32x32x16_bf16(vf, pw[j], o[t], 0, 0, 0);
                    }
            }
            __builtin_amdgcn_s_setprio(0);
        }
        if (kt + 1 < nt) STORE_TILE((kt + 1) & 1);
        __syncthreads();
    }
#undef LOAD_TILE
#undef STORE_TILE
    const float lt = swap32_sum(l_run);
    const float inv = lt > 0.f ? 1.0f / lt : 0.f;
    const size_t Rq = Rb + q_pp;
    bf16* mrow = (qi != 0) ? A.mixed + ((size_t)b * T + (q_pp - 64)) * DM : A.mixm + (size_t)((q_pp - 48) & 15) * DM;
    if (!DIFF) {
        if (store_ok) {
#pragma unroll
            for (int t = 0; t < NTD; ++t)
#pragma unroll
                for (int g = 0; g < 4; ++g) {
                    const int dv0 = 32 * t + 8 * g + 4 * hi;
                    const u32x2 z = *(const u32x2*)(A.P + Rq * NP + zcol + dv0);
                    u32x2 wv; wv.x = cvtpk(o[t][4 * g] * inv * bf_lo(z.x), o[t][4 * g + 1] * inv * bf_hi(z.x)); wv.y = cvtpk(o[t][4 * g + 2] * inv * bf_lo(z.y), o[t][4 * g + 3] * inv * bf_hi(z.y));
                    *(u32x2*)(mrow + mcol + dv0) = wv;
                }
        }
    } else {
        LAS float* xch = (LAS float*)lds;
        if (comp == 1) {
            const float f = inv * A.lam;
#pragma unroll
            for (int t = 0; t < NTD; ++t)
#pragma unroll
                for (int r = 0; r < 16; ++r) xch[(t * 16 + r) * 256 + wq * 64 + lane] = o[t][r] * f;
        }
        __syncthreads();
        if (comp == 0) {
            float ss = 0.f;
#pragma unroll
            for (int t = 0; t < NTD; ++t)
#pragma unroll
                for (int r = 0; r < 16; ++r) { const float v = o[t][r] * inv - xch[(t * 16 + r) * 256 + wq * 64 + lane]; o[t][r] = v; ss += v * v; }
            ss = swap32_sum(ss);
            const float rn = rsqrtf(ss * (1.0f / 128.0f) + NORM_EPS) * A.one_m_li;
            if (store_ok) {
#pragma unroll
                for (int t = 0; t < NTD; ++t)
#pragma unroll
                    for (int g = 0; g < 4; ++g) {
                        const int dv0 = 32 * t + 8 * g + 4 * hi;
                        const u32x2 z = *(const u32x2*)(A.P + Rq * NP + zcol + dv0);
                        const f32x4 sg = *(const f32x4*)(A.subg + h * 128 + dv0);
                        u32x2 wv; wv.x = cvtpk(o[t][4 * g] * rn * sg[0] * bf_lo(z.x), o[t][4 * g + 1] * rn * sg[1] * bf_hi(z.x));
                        wv.y = cvtpk(o[t][4 * g + 2] * rn * sg[2] * bf_lo(z.y), o[t][4 * g + 3] * rn * sg[3] * bf_hi(z.y));
                        *(u32x2*)(mrow + mcol + dv0) = wv;
                    }
            }
        }
        __syncthreads();
    }
}

__device__ __forceinline__ void attn_phase(Frame& F, int layer, int rep) {
    AttnP A; A.P = F.P; A.mixed = F.mix; A.cumloc = F.cumloc; A.cumtot = F.cumtot; A.subg = F.subln_g + layer * 512; A.nrm = F.ctl + 128 + layer * 128; A.mixm = F.mixm;
    A.lam = F.lam[layer]; A.one_m_li = 1.0f - (0.8f - 0.6f * expf(-0.3f * (float)layer));
    LAS int* cur = (LAS int*)(F.lds + LDS_MISC);
    unsigned* counter = F.ctl + 16 * (layer + 1) + 4 * rep;
    for (;;) {
        if (F.tid == 0) *cur = (int)atomicAdd(counter, 1u);
        __syncthreads();
        const int idx = *cur;
        __syncthreads();
        if (idx >= N_UNITS) break;
        const int u = F.units[layer * N_UNITS + idx];
        if (u < N_DIFF_UNITS) {
#ifndef NO_DIFF
            const int bh = u / 65, qi = u % 65; attn_unit<true>(A, bh >> 2, bh & 3, qi, F.lds);
#endif
        }
#ifndef NO_FOX
        else { const int v = u - N_DIFF_UNITS; const int bh = v / 33, qi = v % 33; attn_unit<false>(A, bh >> 3, bh & 7, qi, F.lds); }
#endif
    }
}

__device__ __forceinline__ void final_phase(Frame& F) {
    const int gw = F.bid * 8 + F.wave, NGW = F.G * 8;
    for (int m = gw; m < NB * T; m += NGW) {
        const float rs = rsqrtf(F.sumsq[2 * MG + m] * (1.0f / DM) + NORM_EPS);
        float* p = F.out + (size_t)m * DM;
#pragma unroll
        for (int j = 0; j < 4; ++j) { const f32x4 v = *(const f32x4*)(p + 4 * F.lane + 256 * j); const f32x4 g = *(const f32x4*)(F.final_g + 4 * F.lane + 256 * j); *(f32x4*)(p + 4 * F.lane + 256 * j) = v * rs * g; }
    }
}

#define XB_TMO      128
#define XB_XCNT(j)  (256  + 64 * (j))
#define XB_XSUB(j)  (1280 + 64 * (j))
#define XB_XGEN(j)  (2304 + 64 * (j))
#define XB_TOP      3328
#define XB_TOPGEN   3392
#define XCD_BAR_WORDS 3456
#define XB_SPIN_CAP (1u << 18)

__device__ __forceinline__ unsigned xb_ld(unsigned* p)              { return __hip_atomic_load(p, __ATOMIC_RELAXED, __HIP_MEMORY_SCOPE_AGENT); }
__device__ __forceinline__ unsigned xb_add(unsigned* p, unsigned v) { return __hip_atomic_fetch_add(p, v, __ATOMIC_RELAXED, __HIP_MEMORY_SCOPE_AGENT); }
__device__ __forceinline__ unsigned xb_xcc_id() { return (unsigned)__builtin_amdgcn_s_getreg((3 << 11) | 20) & 0xFu; }
#define XB_SPIN(cond, bar) do { unsigned _sp = 0; while (cond) { __builtin_amdgcn_s_sleep(1); \
    if ((++_sp & 255u) == 0u) { if (xb_ld(&(bar)[XB_TMO])) break; if (_sp > XB_SPIN_CAP) { atomicAdd(&(bar)[XB_TMO], 1u); break; } } } } while (0)

struct XcdBarrier {
    unsigned* bar; unsigned x;
    volatile LAS unsigned* st;
};

__device__ __forceinline__ XcdBarrier xcd_barrier_post(unsigned* bar, volatile LAS unsigned* st) {
    XcdBarrier b; b.bar = bar; b.x = xb_xcc_id(); b.st = st;
    if (threadIdx.x == 0) (void)xb_add(&bar[XB_XCNT(b.x)], 1u);
    return b;
}
__device__ __forceinline__ void xcd_barrier_complete(unsigned* bar, unsigned x, unsigned& nloc, unsigned& nx) {
    const unsigned G = gridDim.x * gridDim.y * gridDim.z;
    unsigned sum, cnt, mine, sp = 0u;
    for (;;) {
        sum = 0u; cnt = 0u; mine = 0u;
#pragma unroll
        for (unsigned j = 0; j < 16; ++j) { const unsigned c = xb_ld(&bar[XB_XCNT(j)]); sum += c; cnt += (c > 0u) ? 1u : 0u; mine = (j == x) ? c : mine; }
        if (sum == G) break;
        __builtin_amdgcn_s_sleep(1);
        if ((++sp & 255u) == 0u) { if (xb_ld(&bar[XB_TMO])) break; if (sp > XB_SPIN_CAP) { atomicAdd(&bar[XB_TMO], 1u); break; } }
    }
    nloc = mine > 0u ? mine : 1u; nx = cnt > 0u ? cnt : 1u;
}

__device__ __forceinline__ void xcd_barrier(const XcdBarrier& b) {
    asm volatile("s_waitcnt vmcnt(0)" ::: "memory");
    __syncthreads();
    if (threadIdx.x == 0) {
        unsigned* bar = b.bar;
        __builtin_amdgcn_s_waitcnt(0);
        unsigned nloc = b.st[0], nx = b.st[1];
        if (nloc == 0u) { xcd_barrier_complete(bar, b.x, nloc, nx); b.st[0] = nloc; b.st[1] = nx; }
        const unsigned old = xb_add(&bar[XB_XSUB(b.x)], 1u);
        const unsigned gen = old / nloc;
        if (old + 1u == (gen + 1u) * nloc) {
            __builtin_amdgcn_fence(__ATOMIC_RELEASE, "agent");
            asm volatile("s_waitcnt vmcnt(0)" ::: "memory");
            const unsigned og = xb_add(&bar[XB_TOP], 1u);
            const unsigned tg = og / nx;
            if (og + 1u == (tg + 1u) * nx) xb_add(&bar[XB_TOPGEN], 1u);
            else XB_SPIN(xb_ld(&bar[XB_TOPGEN]) == tg, bar);
            __builtin_amdgcn_fence(__ATOMIC_ACQUIRE, "agent");
            xb_add(&bar[XB_XGEN(b.x)], 1u);
            asm volatile("s_waitcnt vmcnt(0)" ::: "memory");
        } else {
            XB_SPIN(xb_ld(&bar[XB_XGEN(b.x)]) == gen, bar);
            __builtin_amdgcn_fence(__ATOMIC_ACQUIRE, "agent");
            asm volatile("s_waitcnt vmcnt(0)" ::: "memory");
        }
    }
    __syncthreads();
}

struct Args { const float* in[12]; float* out; unsigned char* ws; int ph_lo, ph_hi; };
typedef const __attribute__((address_space(4))) Args* kargp;
__device__ __forceinline__ void make_frame(Frame& F, ldsp lds) {
    kargp ap = (kargp)__builtin_amdgcn_kernarg_segment_ptr();
    asm volatile("" : "+s"(ap));
    int tid = threadIdx.x; asm volatile("" : "+v"(tid));
    F.lds = lds; F.tid = tid; F.lane = tid & 63; F.wave = __builtin_amdgcn_readfirstlane(tid >> 6); F.G = gridDim.x; F.bid = blockIdx.x;
    F.x = ap->in[0]; F.meta = ap->in[1]; F.norm_g = ap->in[2]; F.w_in = ap->in[3]; F.b_forget = ap->in[4]; F.lq1 = ap->in[5]; F.lk1 = ap->in[6]; F.lq2 = ap->in[7]; F.lk2 = ap->in[8];
    F.subln_g = ap->in[9]; F.w_out = ap->in[10]; F.final_g = ap->in[11]; F.out = ap->out; F.ws = ap->ws;
    unsigned char* ws = ap->ws;
    F.ctl = (unsigned*)(ws + WS_CTL); F.lam = (float*)(ws + WS_LAM); F.units = (int*)(ws + WS_UNITS); F.sumsq = (float*)(ws + WS_SUMSQ); F.cumtot = (float*)(ws + WS_CUMTOT); F.cumloc = (float*)(ws + WS_CUMLOC);
    F.hside = (float*)(ws + WS_HSIDE); F.rope = (float*)(ws + WS_ROPE); F.win_t = (bf16*)(ws + WS_WIN); F.wout_t = (bf16*)(ws + WS_WOUT); F.hb = (bf16*)(ws + WS_HB); F.mix = (bf16*)(ws + WS_MIX); F.P = (bf16*)(ws + WS_P); F.mixm = (bf16*)(ws + WS_HSIDE + 128 * 1024);
}
__global__ void __launch_bounds__(512) hymba_fwd(Args args) {
    extern __shared__ __attribute__((aligned(16))) unsigned char lds_raw[];
    const ldsp lds = (ldsp)lds_raw;
    const int lo = args.ph_lo, hi = args.ph_hi;
    const bool fuse_final = (lo == 0 && hi == 8 && gridDim.x == 256);
    volatile LAS unsigned* bst = (volatile LAS unsigned*)(lds + LDS_MISC + 128);
    if (threadIdx.x < 2) bst[threadIdx.x] = 0u;
    __syncthreads();
    XcdBarrier xbar; xbar.bar = (unsigned*)(args.ws + WS_BAR); xbar.x = 0; xbar.st = bst;
    if (hi - lo > 1) xbar = xcd_barrier_post((unsigned*)(args.ws + WS_BAR), bst);
    if (lo < 0) cg::this_grid().sync();
#define IN(k) (lo <= (k) && (k) < hi)
#define SEAM(k) do { if (IN(k) && IN((k) + 1)) { xcd_barrier(xbar); } } while (0)
#ifndef REP_PRO
#define REP_PRO 1
#endif
#ifndef REP_IN
#define REP_IN 1
#endif
#ifndef REP_ATTN
#define REP_ATTN 1
#endif
    if (IN(0)) { for (int rep = 0; rep < REP_PRO; ++rep) { Frame F; make_frame(F, lds); p0_prologue(F); if (rep + 1 < REP_PRO) xcd_barrier(xbar); } }
    SEAM(0);
#pragma unroll 1
    for (int layer = 0; layer < 2; ++layer) {
        const int pb = 1 + 3 * layer;
        if (IN(pb)) { for (int rep = 0; rep < REP_IN; ++rep) {
#ifndef NO_FORGET
            { Frame F; make_frame(F, lds); for (int tile = F.bid; tile < MG / 64; tile += F.G) forget_item(F, layer, tile);
              for (int it = F.G - 1 - F.bid; it < 257; it += F.G) meta_item<0>(F, layer, it); }
#endif
#ifndef NO_GIN
            { Frame F; make_frame(F, lds);
              pg8::Gemm g{F.hb, F.win_t + (size_t)layer * NP * DM, MG, NP, DM}; pg8::StaticOrder S; S.init(MG, NP, F.G, F.bid);
              pg8::EpiIn E{F.P, F.sumsq + layer * MG, F.rope, F.ctl + 128 + layer * 128};
              pg8::gemm_phase<pg8::EpiIn, pg8::StaticOrder, true, true>(F.lds, g, S, E); }
#endif
        } }
        SEAM(pb);
        if (IN(pb + 1)) { for (int rep = 0; rep < REP_ATTN; ++rep) { Frame F; make_frame(F, lds); attn_phase(F, layer, rep); } }
        SEAM(pb + 1);
        if (IN(pb + 2)) {
#ifndef NO_GOUT
            Frame F; make_frame(F, lds);
            if (layer == 0) { for (int it = F.bid; it < DM / 16; it += F.G) meta_item<1>(F, layer, it); }
            pg8::Gemm g{F.mix, F.wout_t + (size_t)layer * DM * DM, MG, DM, DM}; pg8::StaticOrder S; S.init(MG, DM, F.G, F.bid);
            if (layer == 1 && fuse_final) {
                pg8::EpiOutFinal E{(const float*)F.out, F.out, F.sumsq + 2 * MG, F.ctl + 448, F.final_g};
                pg8::gemm_phase<pg8::EpiOutFinal, pg8::StaticOrder, true, true>(F.lds, g, S, E);
            } else {
                pg8::EpiOut E{layer == 0 ? F.x : (const float*)F.out, F.out, F.hb, F.sumsq + (layer + 1) * MG, layer == 0 ? 1 : 0};
                pg8::gemm_phase<pg8::EpiOut, pg8::StaticOrder, true, true>(F.lds, g, S, E);
            }
#endif
        }
        if (!(layer == 1 && fuse_final)) SEAM(pb + 2);
    }
    if (IN(7) && !fuse_final) { Frame F; make_frame(F, lds); final_phase(F); }
#undef IN
#undef SEAM
}

extern "C" void kernel_launch(void* const* d_in, const int* in_sizes, int n_in, void* d_out, int out_size, void* d_ws, size_t ws_size, hipStream_t stream) {
    static int grid = 0;
    if (grid == 0) {
        if (n_in != 12 || out_size != NB * T * DM || ws_size < WS_END) { fprintf(stderr, "kernel_launch: unexpected shapes (n_in %d out %d ws %zu)\n", n_in, out_size, ws_size); grid = -1; return; }
        int dev = 0, cus = 0, per_cu = 0;
        (void)hipGetDevice(&dev); (void)hipDeviceGetAttribute(&cus, hipDeviceAttributeMultiprocessorCount, dev);
        if (hipFuncSetAttribute((const void*)hymba_fwd, hipFuncAttributeMaxDynamicSharedMemorySize, LDS_BYTES) != hipSuccess) { fprintf(stderr, "kernel_launch: hipFuncSetAttribute failed\n"); grid = -1; return; }
        if (hipOccupancyMaxActiveBlocksPerMultiprocessor(&per_cu, (const void*)hymba_fwd, 512, LDS_BYTES) != hipSuccess || per_cu < 1) per_cu = 1;
        (void)hipGetLastError();
        grid = cus * per_cu;
        if (grid <= 0) grid = 256;
    }
    if (grid < 0) return;
    Args a{};
    for (int i = 0; i < 12; ++i) a.in[i] = (const float*)d_in[i];
    a.out = (float*)d_out; a.ws = (unsigned char*)d_ws;
#if MK_SINGLE
    (void)hipMemsetAsync((unsigned char*)d_ws + WS_BAR, 0, 16384, stream);
    a.ph_lo = 0; a.ph_hi = 8;
    void* kargs[] = {&a};
    hipError_t e = hipLaunchCooperativeKernel((const void*)hymba_fwd, dim3(grid), dim3(512), kargs, LDS_BYTES, stream);
    if (e != hipSuccess) fprintf(stderr, "cooperative launch failed: %s (grid %d)\n", hipGetErrorString(e), grid);
#else
    for (int p = 0; p < 8; ++p) {
        a.ph_lo = p; a.ph_hi = p + 1;
        hipLaunchKernelGGL(hymba_fwd, dim3(grid), dim3(512), LDS_BYTES, stream, a);
    }
#endif
}
```

```cpp
#include <hip/hip_runtime.h>
#include <hip/hip_cooperative_groups.h>
#include <cstdio>
#include <cstdint>
#include <cmath>
namespace cg = cooperative_groups;

#ifndef MK_SINGLE
#define MK_SINGLE 1
#endif

constexpr int MG = 16384;
constexpr int NB = 2, T = 8192, NMETA = 16, LP = 8256, MV = 2 * LP  , MR = 16640, DM = 1024, NP = 4096, PW = 4104, TPB = LP / 64  , NT64 = MV / 64  ;
constexpr float LOG2E = 1.4426950408889634f;
constexpr float C2 = 0.125f * LOG2E;
constexpr float NORM_EPS = 1e-6f;

__device__ __forceinline__ bool row_valid(int R) { if (R >= MV) return false; const int pp = R >= LP ? R - LP : R; return pp >= 48; }
__device__ __forceinline__ int row_pos(int R) { const int pp = R >= LP ? R - LP : R; return pp - 48; }
__device__ __forceinline__ float* hrow(float* out, float* hside, int R) {
    if (R >= MV) return hside + (size_t)(128 + R - MV) * DM;
    const int b = R >= LP ? 1 : 0, pp = R - b * LP;
    if (pp < 64) return hside + (size_t)(b * 64 + pp) * DM;
    return out + ((size_t)b * T + (pp - 64)) * DM;
}

namespace pg8 {
#define PG8_LAS __attribute__((address_space(3)))
typedef unsigned short bf16_t;
typedef short bf16x8 __attribute__((ext_vector_type(8)));
typedef float f32x4 __attribute__((ext_vector_type(4)));
typedef unsigned u32x4 __attribute__((ext_vector_type(4)));
constexpr int BM = 256, BK = 64, HALF = 128, HTB = HALF * BK * 2  , STAGE_BYTES = 8 * HTB, NXCD = 8, WGM = 8;

__host__ __device__ __forceinline__ int lds_byte(int r, int c) { const int st = (r >> 4) * 2 + (c >> 5), rr = r & 15, cc = c & 31, ob = rr * 64 + cc * 2; return st * 1024 + (ob ^ (((ob >> 9) & 1) << 5)); }
__host__ __device__ __forceinline__ void stage_rc(int b, int& R, int& C) { const int st = b / 1024, sb = b % 1024, swz = sb ^ (((sb >> 9) & 1) << 5); R = (st >> 1) * 16 + swz / 64; C = (st & 1) * 32 + (swz % 64) / 2; }
__host__ __device__ __forceinline__ int perm32(int rho) { const int n = rho >> 4, i = rho & 15; return 8 * (i >> 2) + 4 * n + (i & 3); }

struct Unit { int pm, pn; };
struct Gemm { const bf16_t* A; const bf16_t* Bt; int M, N, K; };

struct StaticOrder {
    int nM, nN, nwg, G, c;
    __host__ __device__ void init(int M, int N, int G_, int c_) { nM = M / BM; nN = N / BM; nwg = nM * nN; G = G_; c = c_; }
    __host__ __device__ bool next(int i, Unit& u) const {
        const long L = (long)i * G + c; if (L >= nwg) return false;
        int wgid = (int)L; { const int q = nwg / NXCD, r = nwg % NXCD, xcd = wgid % NXCD, off = wgid / NXCD; wgid = (xcd < r ? xcd * (q + 1) : r * (q + 1) + (xcd - r) * q) + off; }
        const int nig = WGM * nN, gid = wgid / nig, fm = gid * WGM, gsz = (nM - fm) < WGM ? (nM - fm) : WGM;
        u.pm = fm + ((wgid % nig) % gsz); u.pn = (wgid % nig) / gsz; return true;
    }
    __device__ __forceinline__ void a_ready(const Unit&) const {}
    __device__ __forceinline__ void done(const Unit&) const {}
};


__device__ __forceinline__ unsigned cvt_pk_bf16(float lo, float hi) { unsigned r; asm volatile("v_cvt_pk_bf16_f32 %0, %1, %2" : "=v"(r) : "v"(lo), "v"(hi)); return r; }
typedef unsigned u32x2 __attribute__((ext_vector_type(2)));
struct EpiIn {
    static constexpr bool PERM = true, AFTER_DRAIN = false;
    bf16_t* P; const float* sumsq; const float* rope; unsigned* nrm;
    __device__ __forceinline__ void operator()(const f32x4 (&acc)[2][2][4][2], const Unit& u, int wr, int wc, int fr, int fq) const {
        const int pn = u.pn;
        const int mode = (pn < 4) ? 1 : ((pn == 6 || pn == 7 || pn >= 14) ? 2 : 0);
        const float sc = (pn < 2 || pn == 8 || pn == 9) ? C2 : 1.f;
        const int colb = pn * 256 + wc * 32 + 8 * fq;
        float mxb[2] = {0.f, 0.f};
#pragma unroll
        for (int ai = 0; ai < 2; ++ai)
#pragma unroll
            for (int m = 0; m < 4; ++m) {
                const int row = u.pm * BM + ai * HALF + wr * 64 + m * 16 + fr;
                const float rs = rsqrtf(sumsq[row] * (1.0f / DM) + NORM_EPS) * sc;
                const int bb = row >> 13, tt = row & 8191; const size_t R = (size_t)bb * LP + 64 + tt; const int pos = 16 + tt;
#pragma unroll
                for (int bj = 0; bj < 2; ++bj) {
                    const int col = colb + bj * HALF;
                    f32x4 v0 = acc[ai][bj][m][0] * rs, v1 = acc[ai][bj][m][1] * rs;
                    if (mode == 1) {
                        const int j0 = (col & 63) >> 1;
                        const f32x4* cs = (const f32x4*)(rope + ((size_t)pos * 32 + j0) * 2);
                        const f32x4 a = cs[0], b = cs[1];
                        f32x4 w0, w1;
                        w0[0] = v0[0] * a[0] - v0[1] * a[1]; w0[1] = v0[1] * a[0] + v0[0] * a[1];
                        w0[2] = v0[2] * a[2] - v0[3] * a[3]; w0[3] = v0[3] * a[2] + v0[2] * a[3];
                        w1[0] = v1[0] * b[0] - v1[1] * b[1]; w1[1] = v1[1] * b[0] + v1[0] * b[1];
                        w1[2] = v1[2] * b[2] - v1[3] * b[3]; w1[3] = v1[3] * b[2] + v1[2] * b[3];
                        v0 = w0; v1 = w1;
                    } else if (mode == 2) {
#pragma unroll
                        for (int i = 0; i < 4; ++i) { v0[i] = v0[i] * __builtin_amdgcn_rcpf(1.f + __builtin_amdgcn_exp2f(-v0[i] * LOG2E)); v1[i] = v1[i] * __builtin_amdgcn_rcpf(1.f + __builtin_amdgcn_exp2f(-v1[i] * LOG2E)); }
                    }
                    u32x4 w; w.x = cvt_pk_bf16(v0[0], v0[1]); w.y = cvt_pk_bf16(v0[2], v0[3]); w.z = cvt_pk_bf16(v1[0], v1[1]); w.w = cvt_pk_bf16(v1[2], v1[3]);
                    *(u32x4*)(P + R * NP + col) = w;
                    if (pn >= 8 && pn < 12) { float ss = (v0[0] * v0[0] + v0[1] * v0[1]) + (v0[2] * v0[2] + v0[3] * v0[3]) + (v1[0] * v1[0] + v1[1] * v1[1]) + (v1[2] * v1[2] + v1[3] * v1[3]);
                        ss += __shfl_xor(ss, 16); ss += __shfl_xor(ss, 32); mxb[bj] = fmaxf(mxb[bj], ss); }
                }
            }
        if (pn >= 8 && pn < 12) {
#pragma unroll
            for (int bj = 0; bj < 2; ++bj) { float mx = mxb[bj];
#pragma unroll
                for (int o = 1; o < 16; o <<= 1) mx = fmaxf(mx, __shfl_xor(mx, o));
                if (fr == 0 && fq == 0) atomicMax(nrm + (((pn >= 10) ? 8 : 0) + (pn & 1) * 4 + bj * 2 + (wc >> 1)) * 2 + (wc & 1), __float_as_uint(mx)); }
        }
    }
};
struct EpiOut {
    static constexpr bool PERM = false, AFTER_DRAIN = false;
    const float* base; float* out; bf16_t* hb; float* sumsq_next; int write_hb;
    __device__ __forceinline__ void operator()(const f32x4 (&acc)[2][2][4][2], const Unit& u, int wr, int wc, int fr, int fq) const {
        const int col0 = u.pn * BM + wc * 32 + 4 * fq;
#pragma unroll
        for (int ai = 0; ai < 2; ++ai)
#pragma unroll
            for (int m = 0; m < 4; ++m) {
                const int row = u.pm * BM + ai * HALF + wr * 64 + m * 16 + fr;
                float* hp = out + (size_t)row * DM; const float* bp = base + (size_t)row * DM;
                float ss = 0.f;
#pragma unroll
                for (int bj = 0; bj < 2; ++bj)
#pragma unroll
                    for (int n = 0; n < 2; ++n) {
                        const int c = col0 + bj * HALF + n * 16;
                        const f32x4 hv = *(const f32x4*)(bp + c);
                        f32x4 o = hv + acc[ai][bj][m][n];
                        *(f32x4*)(hp + c) = o;
                        ss += (o[0] * o[0] + o[1] * o[1]) + (o[2] * o[2] + o[3] * o[3]);
                        if (write_hb) { u32x2 w; w.x = cvt_pk_bf16(o[0], o[1]); w.y = cvt_pk_bf16(o[2], o[3]); *(u32x2*)(hb + (size_t)row * DM + c) = w; }
                    }
                ss += __shfl_xor(ss, 16); ss += __shfl_xor(ss, 32);
                if (fq == 0) atomicAdd(sumsq_next + row, ss);
            }
    }
};
struct EpiOutFinal {
    static constexpr bool PERM = false, AFTER_DRAIN = false;
    const float* base; float* out; float* sumsq; unsigned* cnt; const float* fg;
    __device__ __forceinline__ void operator()(f32x4 (&acc)[2][2][4][2], const Unit& u, int wr, int wc, int fr, int fq) const {
        const int col0 = u.pn * BM + wc * 32 + 4 * fq;
#pragma unroll
        for (int ai = 0; ai < 2; ++ai)
#pragma unroll
            for (int m = 0; m < 4; ++m) {
                const int row = u.pm * BM + ai * HALF + wr * 64 + m * 16 + fr;
                const float* bp = base + (size_t)row * DM;
                float ss = 0.f;
#pragma unroll
                for (int bj = 0; bj < 2; ++bj)
#pragma unroll
                    for (int n = 0; n < 2; ++n) {
                        const f32x4 o = *(const f32x4*)(bp + col0 + bj * HALF + n * 16) + acc[ai][bj][m][n];
                        acc[ai][bj][m][n] = o;
                        ss += (o[0] * o[0] + o[1] * o[1]) + (o[2] * o[2] + o[3] * o[3]);
                    }
                ss += __shfl_xor(ss, 16); ss += __shfl_xor(ss, 32);
                if (fq == 0) atomicAdd(sumsq + row, ss);
            }
        asm volatile("s_waitcnt vmcnt(0)" ::: "memory");
        __syncthreads();
        if (threadIdx.x == 0) {
            __hip_atomic_fetch_add(cnt + u.pm, 1u, __ATOMIC_RELAXED, __HIP_MEMORY_SCOPE_AGENT);
            unsigned spins = 0;
            while (__hip_atomic_load(cnt + u.pm, __ATOMIC_RELAXED, __HIP_MEMORY_SCOPE_AGENT) < 4u && ++spins < (1u << 22)) __builtin_amdgcn_s_sleep(1);
        }
        __syncthreads();
#pragma unroll
        for (int ai = 0; ai < 2; ++ai)
#pragma unroll
            for (int m = 0; m < 4; ++m) {
                const int row = u.pm * BM + ai * HALF + wr * 64 + m * 16 + fr;
                const float ssr = __hip_atomic_load(sumsq + row, __ATOMIC_RELAXED, __HIP_MEMORY_SCOPE_AGENT);
                const float r = rsqrtf(ssr * (1.0f / DM) + NORM_EPS);
#pragma unroll
                for (int bj = 0; bj < 2; ++bj)
#pragma unroll
                    for (int n = 0; n < 2; ++n) {
                        const int c = col0 + bj * HALF + n * 16;
                        const f32x4 g = *(const f32x4*)(fg + c);
                        *(f32x4*)(out + (size_t)row * DM + c) = acc[ai][bj][m][n] * r * g;
                    }
            }
    }
};

template <class Epi, class Sched, bool ALIGN_EPI = false, bool SP2 = false>
__device__ __forceinline__ void gemm_phase(PG8_LAS unsigned char* lds, const Gemm g, const Sched& S, const Epi& E) {
    int tid_ = threadIdx.x; asm volatile("" : "+v"(tid_));
    const int tid = tid_, wid = __builtin_amdgcn_readfirstlane(tid >> 6), lane = tid & 63, wr = wid >> 2, wc = wid & 3, fr = lane & 15, fq = lane >> 4;
    const int K = g.K, nt = K / BK;
    unsigned voffA[2], voffB[2];
#pragma unroll
    for (int i = 0; i < 2; ++i) { int R, C; stage_rc(tid * 16 + i * 8192, R, C); const int Rb = Epi::PERM ? ((R & ~31) + perm32(R & 31)) : R;
        voffA[i] = (unsigned)(R * K + C) * 2u; voffB[i] = (unsigned)(Rb * K + C) * 2u; }
    const size_t kstep = (size_t)(BK * 2);
    const size_t hstep = (size_t)HALF * K * 2;
    const size_t tstep = 2 * hstep;
    const unsigned ldsw = (unsigned)wid * 1024u;
    const int aoff = lds_byte(wr * 64 + fr, fq * 8), boff = lds_byte(wc * 32 + fr, fq * 8);
#define PG8_SA(b, h) (((b) * 2 + (h)) * HTB)
#define PG8_SB(b, h) ((4 + (b) * 2 + (h)) * HTB)
#define PG8_STAGE(bufoff, gbase, voff) do { _Pragma("unroll") for (int _i = 0; _i < 2; ++_i) \
        __builtin_amdgcn_global_load_lds((const unsigned*)((const char*)(gbase) + (voff)[_i]), (PG8_LAS unsigned*)(lds + (bufoff) + ldsw + _i * 8192), 16, 0, 0); } while (0)
#define PG8_LDA(dst, b, h) do { _Pragma("unroll") for (int m = 0; m < 4; ++m) _Pragma("unroll") for (int k = 0; k < 2; ++k) dst[m][k] = *(const PG8_LAS bf16x8*)(lds + PG8_SA(b, h) + aoff + m * 2048 + k * 1024); } while (0)
#define PG8_LDB(dst, b, h) do { _Pragma("unroll") for (int n = 0; n < 2; ++n) _Pragma("unroll") for (int k = 0; k < 2; ++k) dst[n][k] = *(const PG8_LAS bf16x8*)(lds + PG8_SB(b, h) + boff + n * 2048 + k * 1024); } while (0)
#define PG8_MMA(ai, bj, At, Bt) do { __builtin_amdgcn_s_setprio(1); _Pragma("unroll") for (int m = 0; m < 4; ++m) _Pragma("unroll") for (int n = 0; n < 2; ++n) _Pragma("unroll") for (int k = 0; k < 2; ++k) \
        acc[ai][bj][m][n] = __builtin_amdgcn_mfma_f32_16x16x32_bf16(Bt[n][k], At[m][k], acc[ai][bj][m][n], 0, 0, 0); __builtin_amdgcn_s_setprio(0); } while (0)
#define PG8_WAIT_V(n) asm volatile("s_waitcnt vmcnt(" #n ")" ::: "memory")
#define PG8_WAIT_L(n) asm volatile("s_waitcnt lgkmcnt(" #n ")" ::: "memory")
#define PG8_BAR __builtin_amdgcn_s_barrier()
#define PG8_SCHED __builtin_amdgcn_sched_barrier(0)
    Unit cur, nxt; int ui = 0;
    if (!S.next(0, cur)) return;
    f32x4 acc[2][2][4][2];
#pragma unroll
    for (int a = 0; a < 2; ++a)
#pragma unroll
        for (int b = 0; b < 2; ++b)
#pragma unroll
            for (int m = 0; m < 4; ++m)
#pragma unroll
                for (int n = 0; n < 2; ++n) acc[a][b][m][n] = (f32x4){0.f, 0.f, 0.f, 0.f};
    bf16x8 At[4][2], B0[2][2], B1[2][2];
    const char* cA = (const char*)g.A + (size_t)cur.pm * tstep; const char* cB = (const char*)g.Bt + (size_t)cur.pn * tstep;
    S.a_ready(cur);
    if constexpr (SP2) {
        PG8_STAGE(PG8_SB(0, 0), cB, voffB); PG8_STAGE(PG8_SB(0, 1), cB + hstep, voffB); PG8_STAGE(PG8_SA(0, 0), cA, voffA); PG8_STAGE(PG8_SA(0, 1), cA + hstep, voffA);
        if (wr == 1) PG8_BAR;
        PG8_WAIT_V(2); PG8_BAR;
        PG8_STAGE(PG8_SB(1, 0), cB + kstep, voffB); PG8_STAGE(PG8_SA(1, 0), cA + kstep, voffA); PG8_STAGE(PG8_SB(1, 1), cB + hstep + kstep, voffB);
        PG8_WAIT_V(6); PG8_BAR;
    } else {
        PG8_STAGE(PG8_SB(0, 0), cB, voffB); PG8_STAGE(PG8_SA(0, 0), cA, voffA); PG8_STAGE(PG8_SB(0, 1), cB + hstep, voffB); PG8_STAGE(PG8_SA(0, 1), cA + hstep, voffA);
        if (wr == 1) PG8_BAR;
        PG8_WAIT_V(4); PG8_BAR;
        PG8_STAGE(PG8_SB(1, 0), cB + kstep, voffB); PG8_STAGE(PG8_SA(1, 0), cA + kstep, voffA); PG8_STAGE(PG8_SB(1, 1), cB + hstep + kstep, voffB);
        PG8_WAIT_V(6); PG8_BAR;
    }
    for (;;) {
        const bool has_next = S.next(ui + 1, nxt);
        const char* nA = has_next ? (const char*)g.A + (size_t)nxt.pm * tstep : cA; const char* nB = has_next ? (const char*)g.Bt + (size_t)nxt.pn * tstep : cB;
        for (int t = 0; t < nt; t += 2) {
            const bool last = (t == nt - 2);
            const char* a1 = cA + (size_t)(t + 1) * kstep;
            const char* a2 = last ? nA : cA + (size_t)(t + 2) * kstep; const char* b2 = last ? nB : cB + (size_t)(t + 2) * kstep;
            const char* a3 = a2 + kstep; const char* b3 = b2 + kstep;
            if (last && has_next) S.a_ready(nxt);
            if constexpr (SP2) {
            PG8_LDB(B0, 0, 0); PG8_LDB(B1, 0, 1); PG8_SCHED; PG8_LDA(At, 0, 0); PG8_STAGE(PG8_SA(1, 1), a1 + hstep, voffA);
            PG8_WAIT_V(8); PG8_WAIT_L(0); PG8_BAR; PG8_MMA(0, 0, At, B0); PG8_MMA(0, 1, At, B1); PG8_BAR; PG8_SCHED;
            PG8_LDA(At, 0, 1); PG8_STAGE(PG8_SB(0, 0), b2, voffB); PG8_STAGE(PG8_SB(0, 1), b2 + hstep, voffB); PG8_STAGE(PG8_SA(0, 0), a2, voffA);
            PG8_WAIT_V(8); PG8_WAIT_L(0); PG8_BAR; PG8_MMA(1, 0, At, B0); PG8_MMA(1, 1, At, B1); PG8_BAR; PG8_SCHED;
            PG8_LDB(B0, 1, 0); PG8_LDB(B1, 1, 1); PG8_SCHED; PG8_LDA(At, 1, 0); PG8_STAGE(PG8_SA(0, 1), a2 + hstep, voffA);
            PG8_WAIT_V(8); PG8_WAIT_L(0); PG8_BAR; PG8_MMA(0, 0, At, B0); PG8_MMA(0, 1, At, B1); PG8_BAR; PG8_SCHED;
            PG8_LDA(At, 1, 1); PG8_STAGE(PG8_SB(1, 0), b3, voffB); PG8_STAGE(PG8_SB(1, 1), b3 + hstep, voffB); PG8_STAGE(PG8_SA(1, 0), a3, voffA);
            PG8_WAIT_V(8); PG8_WAIT_L(0); PG8_BAR; PG8_MMA(1, 0, At, B0); PG8_MMA(1, 1, At, B1); PG8_BAR; PG8_SCHED;
            } else {
            PG8_LDB(B0, 0, 0); PG8_SCHED; PG8_LDA(At, 0, 0); PG8_STAGE(PG8_SA(1, 1), a1 + hstep, voffA);
            PG8_WAIT_L(8); PG8_BAR; PG8_WAIT_L(0); PG8_MMA(0, 0, At, B0); PG8_BAR; PG8_SCHED;
            PG8_LDB(B1, 0, 1); PG8_STAGE(PG8_SB(0, 0), b2, voffB);
            PG8_BAR; PG8_WAIT_L(0); PG8_MMA(0, 1, At, B1); PG8_BAR;
            PG8_LDA(At, 0, 1); PG8_STAGE(PG8_SA(0, 0), a2, voffA);
            PG8_BAR; PG8_WAIT_L(0); PG8_MMA(1, 0, At, B0); PG8_BAR; PG8_SCHED;
            PG8_STAGE(PG8_SB(0, 1), b2 + hstep, voffB);
            PG8_WAIT_V(6); PG8_BAR; PG8_MMA(1, 1, At, B1); PG8_BAR;
            PG8_LDB(B0, 1, 0); PG8_SCHED; PG8_LDA(At, 1, 0); PG8_STAGE(PG8_SA(0, 1), a2 + hstep, voffA);
            PG8_WAIT_L(8); PG8_BAR; PG8_WAIT_L(0); PG8_MMA(0, 0, At, B0); PG8_BAR; PG8_SCHED;
            PG8_LDB(B1, 1, 1); PG8_STAGE(PG8_SB(1, 0), b3, voffB);
            PG8_BAR; PG8_WAIT_L(0); PG8_MMA(0, 1, At, B1); PG8_BAR;
            PG8_LDA(At, 1, 1); PG8_STAGE(PG8_SA(1, 0), a3, voffA);
            PG8_BAR; PG8_WAIT_L(0); PG8_MMA(1, 0, At, B0); PG8_BAR; PG8_SCHED;
            PG8_STAGE(PG8_SB(1, 1), b3 + hstep, voffB);
            PG8_WAIT_V(6); PG8_BAR; PG8_MMA(1, 1, At, B1); PG8_BAR;
            }
        }
        if constexpr (ALIGN_EPI) { if (wr == 0) PG8_BAR; }
        if constexpr (!Epi::AFTER_DRAIN) { E(acc, cur, wr, wc, fr, fq); S.done(cur); }
        if (!has_next) break;
#pragma unroll
        for (int a = 0; a < 2; ++a)
#pragma unroll
            for (int b = 0; b < 2; ++b)
#pragma unroll
                for (int m = 0; m < 4; ++m)
#pragma unroll
                    for (int n = 0; n < 2; ++n) acc[a][b][m][n] = (f32x4){0.f, 0.f, 0.f, 0.f};
        cur = nxt; cA = nA; cB = nB; ++ui;
        if constexpr (ALIGN_EPI) { if (wr == 1) PG8_BAR; }
    }
    PG8_WAIT_V(0);
    if constexpr (!ALIGN_EPI) { if (wr == 0) PG8_BAR; }
    PG8_BAR;
    if constexpr (Epi::AFTER_DRAIN) { E.fused(acc, cur, wr, wc, fr, fq, lds, wid, lane); S.done(cur); }
#undef PG8_SA
#undef PG8_SB
#undef PG8_STAGE
#undef PG8_LDA
#undef PG8_LDB
#undef PG8_MMA
#undef PG8_WAIT_V
#undef PG8_WAIT_L
#undef PG8_BAR
#undef PG8_SCHED
}
}

#define LAS __attribute__((address_space(3)))
typedef LAS unsigned char* ldsp;
typedef unsigned short bf16;
typedef short bf16x8 __attribute__((ext_vector_type(8)));
typedef short s16x4 __attribute__((ext_vector_type(4)));
typedef float f32x16 __attribute__((ext_vector_type(16)));
typedef float f32x4 __attribute__((ext_vector_type(4)));
typedef float f32x2 __attribute__((ext_vector_type(2)));
typedef unsigned u32x4 __attribute__((ext_vector_type(4)));
typedef unsigned u32x2 __attribute__((ext_vector_type(2)));
typedef __bf16 bf16x2_t __attribute__((ext_vector_type(2)));
__device__ __forceinline__ unsigned cvtpk(float lo, float hi) { f32x2 v = {lo, hi}; bf16x2_t b = __builtin_convertvector(v, bf16x2_t); return __builtin_bit_cast(unsigned, b); }
__device__ __forceinline__ float bf_lo(unsigned u) { return __uint_as_float(u << 16); }
__device__ __forceinline__ float bf_hi(unsigned u) { return __uint_as_float(u & 0xffff0000u); }
__device__ __forceinline__ float swap32_max(float m) { auto rr = __builtin_amdgcn_permlane32_swap(__float_as_uint(m), __float_as_uint(m), false, false); return fmaxf(__uint_as_float(rr[0]), __uint_as_float(rr[1])); }
__device__ __forceinline__ float swap32_sum(float m) { auto rr = __builtin_amdgcn_permlane32_swap(__float_as_uint(m), __float_as_uint(m), false, false); return __uint_as_float(rr[0]) + __uint_as_float(rr[1]); }
__device__ __forceinline__ int crow(int r, int hi) { return (r & 3) + 8 * (r >> 2) + 4 * hi; }
typedef short v4i16_t __attribute__((ext_vector_type(4)));
__device__ __forceinline__ s16x4 vtr(ldsp p) { return __builtin_bit_cast(s16x4, __builtin_amdgcn_ds_read_tr16_b64_v4i16((LAS v4i16_t*)p)); }
__device__ __forceinline__ float wave_sum(float v) {
#pragma unroll
    for (int o = 1; o < 64; o <<= 1) v += __shfl_xor(v, o);
    return v;
}

constexpr size_t MiB = 1u << 20;
constexpr size_t WS_CTL = 0;
constexpr size_t WS_LAM = 4096;
constexpr size_t WS_UNITS = 8192;
constexpr size_t WS_BAR = 32 * 1024;
constexpr size_t WS_SUMSQ = 64 * 1024;
constexpr size_t WS_CUMTOT = 512 * 1024;
constexpr size_t WS_CUMLOC = 1 * MiB;
constexpr size_t WS_HSIDE = 2 * MiB;
constexpr size_t WS_ROPE = 3 * MiB;
constexpr size_t WS_WIN = 6 * MiB;
constexpr size_t WS_WOUT = 22 * MiB;
constexpr size_t WS_HB = 26 * MiB;
constexpr size_t WS_MIX = 59 * MiB;
constexpr size_t WS_P = 92 * MiB;
constexpr size_t WS_END = 223 * MiB;
static_assert(WS_HB + (size_t)MR * DM * 2 <= WS_MIX && WS_MIX + (size_t)MR * DM * 2 <= WS_P && WS_P + (size_t)MR * NP * 2 <= WS_END, "ws map");
constexpr int N_DIFF_UNITS = 8 * 65, N_FOX_UNITS = 16 * 33, N_UNITS = N_DIFF_UNITS + N_FOX_UNITS;

constexpr int LDS_BYTES = 147456;
constexpr int LDS_PREF = 132 * 1024, LDS_MISC = 133 * 1024;

struct Frame {
    const float *x, *meta, *norm_g, *w_in, *b_forget, *lq1, *lk1, *lq2, *lk2, *subln_g, *w_out, *final_g;
    float* out; unsigned char* ws;
    unsigned* ctl; float* lam; int* units; float* sumsq; float* cumtot; float* cumloc; float* hside; float* rope;
    bf16 *win_t, *wout_t, *hb, *mix, *P, *mixm;
    ldsp lds; int tid, lane, wave, G, bid;
};

__device__ __forceinline__ unsigned f2bf(float f) { unsigned u = __float_as_uint(f); return (u + 0x7fffu + ((u >> 16) & 1u)) >> 16; }
__device__ __forceinline__ unsigned pk2(float lo, float hi) { return f2bf(lo) | (f2bf(hi) << 16); }
__device__ __forceinline__ void transpose_item(const float* W, int ldw, bool ropemap, const float* g, bf16* WT, int nN, LAS float* scr, int item, int lane) {
    const int nblk = nN / 32, kb = item / nblk, nb = item % nblk, k0 = 64 * kb, n0 = 32 * nb;
    const int n = n0 + (lane & 31);
    int col = n; if (ropemap && n < 1024) { const int p = n & 63; col = (n & ~63) + (p >> 1) + 32 * (p & 1); }
    float wv_[32];
#pragma unroll
    for (int i = 0; i < 32; ++i) { const int kk = 2 * i + (lane >> 5); wv_[i] = W[(size_t)(k0 + kk) * ldw + col]; }
#pragma unroll
    for (int i = 0; i < 32; ++i) { const int kk = 2 * i + (lane >> 5); const float gv = g ? g[k0 + kk] : 1.f; scr[kk * 33 + (lane & 31)] = wv_[i] * gv; }
    asm volatile("s_waitcnt lgkmcnt(0)" ::: "memory");
    const int c = lane & 7;
#pragma unroll
    for (int j = 0; j < 4; ++j) { const int nn = (lane >> 3) + 8 * j; const LAS float* s = scr + (8 * c) * 33 + nn;
        u32x4 o; o.x = pk2(s[0 * 33], s[1 * 33]); o.y = pk2(s[2 * 33], s[3 * 33]); o.z = pk2(s[4 * 33], s[5 * 33]); o.w = pk2(s[6 * 33], s[7 * 33]);
        *(u32x4*)(WT + (size_t)(n0 + nn) * DM + k0 + 8 * c) = o; }
    asm volatile("s_waitcnt lgkmcnt(0)" ::: "memory");
}
__device__ __forceinline__ int unit_cost(int u, const float* bfg) {
    if (u < N_DIFF_UNITS) { const int qi = u % 65; return (qi == 0 ? 1 : 1 + 2 * qi) * 4; }
    const int v = u - N_DIFF_UNITS, qi = v % 33, h = (v / 33) & 7;
    const float rate = 1.44f * 1.65f * log1pf(expf(-bfg[h]));
    const int wt = 6 + (int)(95.0f / (64.0f * rate));
    const int full = (qi == 0 ? 1 : 1 + 4 * qi);
    return (full < wt ? full : wt) * 3;
}
__device__ __forceinline__ void p0_prologue(Frame& F) {
    const int gw = F.bid * 8 + F.wave, NGW = F.G * 8, gt = F.bid * 512 + F.tid, NGT = F.G * 512;
    LAS float* scr = (LAS float*)(F.lds + F.wave * 16384);
    constexpr int I_IN = 16 * (NP / 32), I_OUT = 16 * (DM / 32);
    for (int it = gw; it < 2 * (I_IN + I_OUT); it += NGW) {
        int r = it; const int l = r / (I_IN + I_OUT); r -= l * (I_IN + I_OUT);
        if (r < I_IN) transpose_item(F.w_in + (size_t)l * DM * PW, PW, true, F.norm_g + l * DM, F.win_t + (size_t)l * NP * DM, NP, scr, r, F.lane);
        else transpose_item(F.w_out + (size_t)l * DM * DM, DM, false, nullptr, F.wout_t + (size_t)l * DM * DM, DM, scr, r - I_IN, F.lane);
    }
    for (int m0 = gw * 4; m0 < MG; m0 += NGW * 4) {
        f32x4 v[4][4];
#pragma unroll
        for (int q = 0; q < 4; ++q)
#pragma unroll
            for (int j = 0; j < 4; ++j) v[q][j] = *(const f32x4*)(F.x + (size_t)(m0 + q) * DM + 4 * F.lane + 256 * j);
#pragma unroll
        for (int q = 0; q < 4; ++q) {
            const int m = m0 + q; float ss = 0.f;
#pragma unroll
            for (int j = 0; j < 4; ++j) {
                u32x2 w; w.x = pk2(v[q][j][0], v[q][j][1]); w.y = pk2(v[q][j][2], v[q][j][3]);
                *(u32x2*)(F.hb + (size_t)m * DM + 4 * F.lane + 256 * j) = w;
                ss += (v[q][j][0] * v[q][j][0] + v[q][j][1] * v[q][j][1]) + (v[q][j][2] * v[q][j][2] + v[q][j][3] * v[q][j][3]);
            }
            ss = wave_sum(ss);
            if (F.lane == 0) { F.sumsq[m] = ss; F.sumsq[MG + m] = 0.f; F.sumsq[2 * MG + m] = 0.f; }
        }
    }
    for (int i = gt; i < NMETA * DM; i += NGT) F.hside[i] = F.meta[i];
    for (int i = gt; i < 2 * 48 * (NP / 8); i += NGT) { const int rr = i / (NP / 8), c8 = i % (NP / 8); const int R = (rr / 48) * LP + (rr % 48);
        *(u32x4*)(F.P + (size_t)R * NP + c8 * 8) = (u32x4){0u, 0u, 0u, 0u}; }
    for (int i = gt; i < 8208 * 32; i += NGT) {
        const int pos = i >> 5, j = i & 31;
        const double inv = exp2(-(double)j * (13.287712379549449 / 32.0));
        const double ang = (double)pos * inv;
        double s, c; sincos(ang, &s, &c);
        F.rope[2 * i] = (float)c; F.rope[2 * i + 1] = (float)s;
    }
    if (F.bid == 0) {
        F.ctl[F.tid] = 0u;
        if (F.tid < 2) {
            const int l = F.tid; float s1 = 0.f, s2 = 0.f;
            for (int i = 0; i < 64; ++i) { s1 += F.lq1[l * 64 + i] * F.lk1[l * 64 + i]; s2 += F.lq2[l * 64 + i] * F.lk2[l * 64 + i]; }
            const float li = 0.8f - 0.6f * expf(-0.3f * (float)l);
            F.lam[l] = expf(s1) - expf(s2) + li;
        }
    }
    for (int ul = gw; ul < 2 * N_UNITS; ul += NGW) {
        const int l = ul / N_UNITS, u = ul - l * N_UNITS; const float* bfg = F.b_forget + l * 8;
        const int cu = unit_cost(u, bfg); int cnt = 0;
        for (int v = F.lane; v < N_UNITS; v += 64) { const int cv = unit_cost(v, bfg); cnt += (cv > cu || (cv == cu && v < u)) ? 1 : 0; }
#pragma unroll
        for (int o = 1; o < 64; o <<= 1) cnt += __shfl_xor(cnt, o);
        if (F.lane == 0) F.units[l * N_UNITS + cnt] = u;
    }
}

__device__ __forceinline__ void forget_item(Frame& F, int layer, int tile) {
    const float* W = F.w_in + (size_t)layer * DM * PW + 4096; const float* g = F.norm_g + layer * DM; const float* bfg = F.b_forget + layer * 8;
    ldsp wl = F.lds;
    LAS float* lf = (LAS float*)(F.lds + 40960);
#pragma unroll
    for (int q = 0; q < 2; ++q) { const int kk = F.tid + 512 * q; const float gv = g[kk];
        const f32x4 a = *(const f32x4*)(W + (size_t)kk * PW) * gv, b = *(const f32x4*)(W + (size_t)kk * PW + 4) * gv;
        *(LAS f32x4*)(wl + (kk >> 2) * 144 + (kk & 3) * 32) = a; *(LAS f32x4*)(wl + (kk >> 2) * 144 + (kk & 3) * 32 + 16) = b; }
    __syncthreads();
    const int row_l = F.tid >> 3, kp = F.tid & 7;
    const int fb = tile >> 7, fj = tile & 127; const size_t R0 = (size_t)fb * LP + 64 + 64 * fj;
    const float* xp = (layer == 0 ? F.x : (const float*)F.out) + ((size_t)tile * 64 + row_l) * DM;
    float acc[8] = {0.f, 0.f, 0.f, 0.f, 0.f, 0.f, 0.f, 0.f}; float ss = 0.f;
#pragma unroll 1
    for (int bt = 0; bt < 4; ++bt) {
        f32x4 xv[8];
#pragma unroll
        for (int i = 0; i < 8; ++i) xv[i] = *(const f32x4*)(xp + 4 * (kp + 8 * (bt * 8 + i)));
#pragma unroll
        for (int i = 0; i < 8; ++i) { ldsp wg = wl + (kp + 8 * (bt * 8 + i)) * 144;
#pragma unroll
            for (int e = 0; e < 4; ++e) { const float xe = xv[i][e]; ss += xe * xe;
                const f32x4 wa = *(LAS f32x4*)(wg + e * 32), wb = *(LAS f32x4*)(wg + e * 32 + 16);
                acc[0] += xe * wa[0]; acc[1] += xe * wa[1]; acc[2] += xe * wa[2]; acc[3] += xe * wa[3];
                acc[4] += xe * wb[0]; acc[5] += xe * wb[1]; acc[6] += xe * wb[2]; acc[7] += xe * wb[3]; } }
    }
#pragma unroll
    for (int o = 1; o < 8; o <<= 1) { ss += __shfl_xor(ss, o);
#pragma unroll
        for (int j = 0; j < 8; ++j) acc[j] += __shfl_xor(acc[j], o); }
    float mine = acc[0];
#pragma unroll
    for (int j = 1; j < 8; ++j) mine = (kp == j) ? acc[j] : mine;
    {
        const float xl = mine * rsqrtf(ss * (1.0f / DM) + NORM_EPS) + bfg[kp];
        float v = fminf(xl, 0.f) - log1pf(expf(-fabsf(xl)));
        lf[row_l * 8 + kp] = v;
    }
    __syncthreads();
    if (F.wave == 0) {
        const int seg = F.lane >> 3, j = F.lane & 7;
        float vals[8]; float run = 0.f;
#pragma unroll
        for (int i = 0; i < 8; ++i) { run += lf[(seg * 8 + i) * 8 + j]; vals[i] = run; }
        float inc = run;
#pragma unroll
        for (int o = 8; o < 64; o <<= 1) { const float t_ = __shfl_up(inc, o); if (F.lane >= o) inc += t_; }
        const float excl = inc - run;
#pragma unroll
        for (int i = 0; i < 8; ++i) F.cumloc[(R0 + seg * 8 + i) * 8 + j] = (excl + vals[i]) * LOG2E;
        if (seg == 7) F.cumtot[(fb * TPB + 1 + fj) * 8 + j] = inc * LOG2E;
    }
    __syncthreads();
}

template <int MODE>
__device__ __forceinline__ void meta_item(Frame& F, int layer, int item) {
    LAS float* xT = (LAS float*)(F.lds);
    LAS float* red = (LAS float*)(F.lds + 65536);
    LAS float* rr = (LAS float*)(F.lds + 98304);
    LAS float* lfm = (LAS float*)(F.lds + 98304 + 256);
    const float* W = MODE == 0 ? F.w_in + (size_t)layer * DM * PW : F.w_out + (size_t)layer * DM * DM;
    const int ldw = MODE == 0 ? PW : DM;
    const float* g = F.norm_g + layer * DM;
    for (int idx = F.tid; idx < NMETA * DM; idx += 512) { const int row = idx >> 10, k = idx & 1023;
        float v; if (MODE == 0) v = F.hside[idx]; else v = __uint_as_float((unsigned)F.mixm[idx] << 16);
        xT[k * 16 + row] = v; }
    __syncthreads();
    if (MODE == 0) {
        const int row = F.tid >> 5, l32 = F.tid & 31; float ss = 0.f;
#pragma unroll 8
        for (int i = 0; i < 32; ++i) { const float v = xT[(l32 + 32 * i) * 16 + row]; ss += v * v; }
#pragma unroll
        for (int o = 1; o < 32; o <<= 1) ss += __shfl_xor(ss, o);
        if (l32 == 0) rr[row] = rsqrtf(ss * (1.0f / DM) + NORM_EPS);
    }
    const int c = F.tid & 15, ks = F.tid >> 4;
    const int n = item * 16 + c;
    int col = n; bool colok = true;
    if (MODE == 0) { if (n < 1024) { const int p = n & 63; col = (n & ~63) + (p >> 1) + 32 * (p & 1); } colok = n < PW; if (!colok) col = 0; }
    float acc[16];
#pragma unroll
    for (int r = 0; r < 16; ++r) acc[r] = 0.f;
#pragma unroll 1
    for (int k8 = 0; k8 < 4; ++k8) {
        float wv[8];
#pragma unroll
        for (int i = 0; i < 8; ++i) { const int k = ks * 32 + k8 * 8 + i; wv[i] = W[(size_t)k * ldw + col] * (MODE == 0 ? g[k] : 1.f); }
#pragma unroll
        for (int i = 0; i < 8; ++i) { const int k = ks * 32 + k8 * 8 + i;
#pragma unroll
            for (int q = 0; q < 4; ++q) { const f32x4 xv = *(LAS f32x4*)(xT + k * 16 + 4 * q);
                acc[4 * q] += wv[i] * xv[0]; acc[4 * q + 1] += wv[i] * xv[1]; acc[4 * q + 2] += wv[i] * xv[2]; acc[4 * q + 3] += wv[i] * xv[3]; } }
    }
#pragma unroll
    for (int r = 0; r < 16; ++r) red[(ks * 16 + r) * 16 + c] = colok ? acc[r] : 0.f;
    __syncthreads();
    if (F.tid < 256) {
        const int r = F.tid >> 4;
        float v = 0.f;
#pragma unroll 8
        for (int s_ = 0; s_ < 32; ++s_) v += red[(s_ * 16 + r) * 16 + c];
        if (MODE == 1) { F.hside[r * DM + n] += v; }
        else {
            v *= rr[r];
            if (item < 256) {
                const int pn = n >> 8;
                const int mode = (pn < 4) ? 1 : ((pn == 6 || pn == 7 || pn >= 14) ? 2 : 0);
                if (pn < 2 || pn == 8 || pn == 9) v *= C2;
                const float partner = __shfl_xor(v, 1);
                if (mode == 1) { const int j = (n & 63) >> 1; const float cs = F.rope[(r * 32 + j) * 2], sn = F.rope[(r * 32 + j) * 2 + 1];
                    v = (n & 1) ? (v * cs + partner * sn) : (v * cs - partner * sn); }
                else if (mode == 2) v = v * __builtin_amdgcn_rcpf(1.f + __builtin_amdgcn_exp2f(-v * LOG2E));
                const bf16 o = (bf16)f2bf(v);
                F.P[((size_t)48 + r) * NP + n] = o; F.P[((size_t)LP + 48 + r) * NP + n] = o;
                if (pn == 10 || pn == 11) {
                    float ss = v * v;
#pragma unroll
                    for (int o2 = 1; o2 < 16; o2 <<= 1) ss += __shfl_xor(ss, o2);
                    if (c == 0) atomicMax(F.ctl + 128 + layer * 128 + 32 + ((n - 2560) >> 4), __float_as_uint(ss));
                }
            } else if (c < 8) {
                const float xl = v + F.b_forget[layer * 8 + c];
                lfm[r * 8 + c] = fminf(xl, 0.f) - log1pf(expf(-fabsf(xl)));
            }
        }
    }
    __syncthreads();
    if (MODE == 0 && item == 256 && F.tid < 8) {
        float run = 0.f;
        for (int pp = 0; pp < 64; ++pp) { if (pp >= 48) run += lfm[(pp - 48) * 8 + F.tid];
            F.cumloc[(size_t)pp * 8 + F.tid] = run * LOG2E; F.cumloc[((size_t)LP + pp) * 8 + F.tid] = run * LOG2E; }
        F.cumtot[F.tid] = run * LOG2E; F.cumtot[TPB * 8 + F.tid] = run * LOG2E;
    }
    __syncthreads();
}

__device__ __forceinline__ void split3(float x, unsigned& h, unsigned& m, unsigned& l) {
    h = cvtpk(x, 0.f) & 0xffffu; const float r1 = x - __uint_as_float(h << 16);
    m = cvtpk(r1, 0.f) & 0xffffu; const float r2 = r1 - __uint_as_float(m << 16);
    l = cvtpk(r2, 0.f) & 0xffffu;
}
struct AttnP { const bf16* P; bf16* mixed; const float* cumloc; const float* cumtot; const float* subg; const unsigned* nrm; bf16* mixm; float lam; float one_m_li; };

template <bool DIFF>
__device__ __forceinline__ void attn_unit(const AttnP& A, int b, int h, int qi, ldsp lds) {
    constexpr int DV = DIFF ? 128 : 64, NTD = DV / 32, KP = DIFF ? 272 : 144, VP = DIFF ? 320 : 192, QROWS = DIFF ? 128 : 256, TPQ = QROWS / 64;
    constexpr int STAGE = 64 * KP + 64 * VP + 256, NPIECE = DIFF ? 2 : 1;
    int tid_ = threadIdx.x; asm volatile("" : "+v"(tid_));
    const int tid = tid_, lane = tid & 63, w = __builtin_amdgcn_readfirstlane(tid >> 6), r32 = lane & 31, hi = lane >> 5;
    const int comp = DIFF ? (w >> 2) : 0, wq = DIFF ? (w & 3) : w;
    const int qstart = qi == 0 ? 0 : 64 + QROWS * (qi - 1);
    const int nt = qi == 0 ? 1 : 1 + TPQ * qi;
    const int diag0 = qi == 0 ? 0 : nt - TPQ;
    const int q_pp = qstart + 32 * wq + r32, qmax_w = qstart + 32 * wq + 31;
    const bool store_ok = (qi != 0) || (b == 0 && q_pp >= 48 && q_pp < 64);
    const size_t Rb = (size_t)b * LP;
    const int qcol = DIFF ? h * 128 + comp * 64 : 2048 + h * 64;
    const int kcol = DIFF ? 512 + h * 128 : 2560 + h * 64;
    const int vcol = DIFF ? 1024 + h * 128 : 3072 + h * 64;
    const int zcol = DIFF ? 1536 + h * 128 : 3584 + h * 64;
    const int mcol = DIFF ? h * 128 : 512 + h * 64;
    const bf16* Pq = A.P + (Rb + q_pp) * NP;
    bf16x8 qf[4];
#pragma unroll
    for (int c = 0; c < 4; ++c) qf[c] = *(const bf16x8*)(Pq + qcol + 16 * c + 8 * hi);
    LAS float* pref = (LAS float*)(lds + LDS_PREF);
    u32x4 kreg[NPIECE], vreg[NPIECE]; float clreg = 0.f;
#define LOAD_TILE(kt) do { const bf16* base_ = A.P + (Rb + 64 * (size_t)(kt)) * NP; \
        _Pragma("unroll") for (int i_ = 0; i_ < NPIECE; ++i_) { const int p_ = tid + 512 * i_; const int row_ = DIFF ? (p_ >> 4) : (p_ >> 3); const int c16_ = DIFF ? (p_ & 15) : (p_ & 7); \
            kreg[i_] = *(const u32x4*)(base_ + (size_t)row_ * NP + kcol + c16_ * 8); vreg[i_] = *(const u32x4*)(base_ + (size_t)row_ * NP + vcol + c16_ * 8); } \
        if (!DIFF && tid < 64) clreg = A.cumloc[(Rb + 64 * (size_t)(kt) + tid) * 8 + h]; } while (0)
#define STORE_TILE(st) do { ldsp sb_ = lds + (st) * STAGE; \
        _Pragma("unroll") for (int i_ = 0; i_ < NPIECE; ++i_) { const int p_ = tid + 512 * i_; const int row_ = DIFF ? (p_ >> 4) : (p_ >> 3); const int c16_ = DIFF ? (p_ & 15) : (p_ & 7); \
            *(LAS u32x4*)(sb_ + row_ * KP + c16_ * 16) = kreg[i_]; *(LAS u32x4*)(sb_ + 64 * KP + row_ * VP + c16_ * 16) = vreg[i_]; } \
        if (!DIFF && tid < 64) { unsigned h_, m_, l_; split3(-clreg, h_, m_, l_); *(LAS u32x4*)(sb_ + tid * KP + 128) = (u32x4){h_ | (m_ << 16), l_ | 0x3f800000u, 0x3f803f80u, 0u}; } } while (0)
    int kt0 = 0;
    if (!DIFF) {
        LAS int* kst = (LAS int*)(lds + LDS_MISC + 64);
        if (tid == 0) *kst = nt - 1;
        if (w == 0) {
            float carry = 0.f;
#pragma unroll
            for (int ch = 0; ch < 3; ++ch) {
                const int idx = ch * 64 + lane;
                const float v = idx < TPB ? A.cumtot[(b * TPB + idx) * 8 + h] : 0.f;
                float inc = v;
#pragma unroll
                for (int o = 1; o < 64; o <<= 1) { const float t_ = __shfl_up(inc, o); if (lane >= o) inc += t_; }
                if (idx < TPB) pref[idx] = carry + inc - v;
                if (idx == TPB - 1) pref[TPB] = carry + inc;
                carry += __shfl(inc, 63);
            }
        }
        __syncthreads();
        const float q2 = __uint_as_float(A.nrm[(h) * 2]) + __uint_as_float(A.nrm[(h) * 2 + 1]), k2r = __uint_as_float(A.nrm[(8 + h) * 2]) + __uint_as_float(A.nrm[(8 + h) * 2 + 1]),
                    k2m = (__uint_as_float(A.nrm[32 + h * 4]) + __uint_as_float(A.nrm[32 + h * 4 + 1])) + (__uint_as_float(A.nrm[32 + h * 4 + 2]) + __uint_as_float(A.nrm[32 + h * 4 + 3])), k2 = fmaxf(k2r, k2m);
        const float thr = 2.0f * 1.03f * sqrtf(q2 * k2) + 40.0f;
        if (tid < nt) { if (pref[qstart >> 6] - pref[tid + 1] >= -thr) atomicMin((int*)kst, tid); }
        __syncthreads();
        kt0 = *kst;
    }
    LOAD_TILE(kt0);
    STORE_TILE(kt0 & 1);
    __syncthreads();
    float cq = 0.f;
    if (!DIFF) cq = pref[q_pp >> 6] + A.cumloc[(Rb + q_pp) * 8 + h];
    float mhat = 0.f, l_run = 0.f;
    f32x16 negm;
#pragma unroll
    for (int r = 0; r < 16; ++r) negm[r] = 0.f;
    f32x16 o[NTD];
#pragma unroll
    for (int t = 0; t < NTD; ++t)
#pragma unroll
        for (int r = 0; r < 16; ++r) o[t][r] = 0.f;
    const int trb = (4 * hi + ((lane & 15) >> 2)) * VP + ((lane >> 4) & 1) * 32 + (lane & 3) * 8;
    for (int kt = kt0; kt < nt; ++kt) {
        if (kt + 1 < nt) LOAD_TILE(kt + 1);
        if (64 * kt <= qmax_w) {
            ldsp Kb = lds + (kt & 1) * STAGE; ldsp Vb = Kb + 64 * KP;
            bf16x8 kf[8];
#pragma unroll
            for (int c = 0; c < 4; ++c) {
                kf[2 * c] = *(LAS bf16x8*)(Kb + r32 * KP + comp * 128 + c * 32 + hi * 16);
                kf[2 * c + 1] = *(LAS bf16x8*)(Kb + (32 + r32) * KP + comp * 128 + c * 32 + hi * 16);
            }
            __builtin_amdgcn_sched_barrier(0);
            f32x16 s0 = negm, s1 = negm;
            bf16x8 ka0, ka1, qa;
            if (!DIFF) {
                ka0 = *(LAS bf16x8*)(Kb + r32 * KP + 128); ka1 = *(LAS bf16x8*)(Kb + (32 + r32) * KP + 128);
                unsigned h_, m_, l_; split3(cq - pref[kt], h_, m_, l_);
                u32x4 qa_ = (u32x4){0x3f803f80u, 0x3f80u | (h_ << 16), m_ | (l_ << 16), 0u};
                if (hi) qa_ = (u32x4){0u, 0u, 0u, 0u};
                qa = __builtin_bit_cast(bf16x8, qa_);
            }
            __builtin_amdgcn_s_setprio(1);
            if (!DIFF) { s0 = __builtin_amdgcn_mfma_f32_32x32x16_bf16(ka0, qa, s0, 0, 0, 0); s1 = __builtin_amdgcn_mfma_f32_32x32x16_bf16(ka1, qa, s1, 0, 0, 0); }
#pragma unroll
            for (int c = 0; c < 4; ++c) {
                s0 = __builtin_amdgcn_mfma_f32_32x32x16_bf16(kf[2 * c], qf[c], s0, 0, 0, 0);
                s1 = __builtin_amdgcn_mfma_f32_32x32x16_bf16(kf[2 * c + 1], qf[c], s1, 0, 0, 0);
            }
            __builtin_amdgcn_s_setprio(0);
            s16x4 vlo[8], vhi[8];
#pragma unroll
            for (int t = 0; t < 2; ++t)
#pragma unroll
                for (int j = 0; j < 4; ++j) { vlo[t * 4 + j] = vtr(Vb + trb + (16 * j) * VP + t * 64); vhi[t * 4 + j] = vtr(Vb + trb + (16 * j + 8) * VP + t * 64); }
            __builtin_amdgcn_sched_barrier(0);
            if (kt == 0 || kt >= diag0) {
#pragma unroll
                for (int r = 0; r < 16; ++r) { const int kpp = 64 * kt + crow(r, hi);
                    if (kpp < 48 || kpp > q_pp) s0[r] = -INFINITY;
                    if (kpp + 32 < 48 || kpp + 32 > q_pp) s1[r] = -INFINITY; }
            }
            float ma = fmaxf(fmaxf(s0[0], s0[1]), s1[0]), mb = fmaxf(fmaxf(s0[2], s0[3]), s1[1]);
            ma = fmaxf(fmaxf(ma, s1[2]), s1[3]);
#pragma unroll
            for (int r = 4; r < 16; r += 4) { ma = fmaxf(fmaxf(ma, s0[r]), s0[r + 1]); mb = fmaxf(fmaxf(mb, s0[r + 2]), s0[r + 3]); ma = fmaxf(fmaxf(ma, s1[r]), s1[r + 1]); mb = fmaxf(fmaxf(mb, s1[r + 2]), s1[r + 3]); }
            const float rm = swap32_max(fmaxf(ma, mb));
            if (kt == kt0 || __any(rm > 60.0f)) {
                const float dl = (kt == kt0) ? ((rm == -INFINITY) ? 0.f : rm) : fmaxf(rm, 0.f);
                mhat += dl;
#pragma unroll
                for (int r = 0; r < 16; ++r) { s0[r] -= dl; s1[r] -= dl; negm[r] = -mhat; }
                const float f = (kt == kt0) ? 1.0f : __builtin_amdgcn_exp2f(-dl);
                l_run *= f;
#pragma unroll
                for (int t = 0; t < NTD; ++t)
#pragma unroll
                    for (int r = 0; r < 16; ++r) o[t][r] *= f;
            }
            float psa = 0.f, psb = 0.f;
#pragma unroll
            for (int r = 0; r < 16; ++r) { s0[r] = __builtin_amdgcn_exp2f(s0[r]); s1[r] = __builtin_amdgcn_exp2f(s1[r]); psa += s0[r]; asm("" : "+v"(psa)); psb += s1[r]; asm("" : "+v"(psb)); }
            l_run += psa + psb;
            bf16x8 pw[4];
#pragma unroll
            for (int j = 0; j < 4; ++j) {
                u32x4 pk;
                if (j < 2) { const int rb = 8 * (j & 1); pk.x = cvtpk(s0[rb], s0[rb + 1]); pk.y = cvtpk(s0[rb + 2], s0[rb + 3]); pk.z = cvtpk(s0[rb + 4], s0[rb + 5]); pk.w = cvtpk(s0[rb + 6], s0[rb + 7]); }
                else { const int rb = 8 * (j & 1); pk.x = cvtpk(s1[rb], s1[rb + 1]); pk.y = cvtpk(s1[rb + 2], s1[rb + 3]); pk.z = cvtpk(s1[rb + 4], s1[rb + 5]); pk.w = cvtpk(s1[rb + 6], s1[rb + 7]); }
                pw[j] = __builtin_bit_cast(bf16x8, pk);
            }
            __builtin_amdgcn_sched_barrier(0);
            __builtin_amdgcn_s_setprio(1);
#pragma unroll
            for (int t = 0; t < 2; ++t)
#pragma unroll
                for (int j = 0; j < 4; ++j) {
                    const bf16x8 vf = (bf16x8){vlo[t * 4 + j][0], vlo[t * 4 + j][1], vlo[t * 4 + j][2], vlo[t * 4 + j][3], vhi[t * 4 + j][0], vhi[t * 4 + j][1], vhi[t * 4 + j][2], vhi[t * 4 + j][3]};
                    o[t] = __builtin_amdgcn_mfma_f32_32x32x16_bf16(vf, pw[j], o[t], 0, 0, 0);
                }
            if (DIFF) {
#pragma unroll
                for (int t = 2; t < NTD; ++t)
#pragma unroll
                    for (int j = 0; j < 4; ++j) { vlo[(t - 2) * 4 + j] = vtr(Vb + trb + (16 * j) * VP + t * 64); vhi[(t - 2) * 4 + j] = vtr(Vb + trb + (16 * j + 8) * VP + t * 64); }
                __builtin_amdgcn_sched_barrier(0);
#pragma unroll
                for (int t = 2; t < NTD; ++t)
#pragma unroll
                    for (int j = 0; j < 4; ++j) {
                        const int i = (t - 2) * 4 + j;
                        const bf16x8 vf = (bf16x8){vlo[i][0], vlo[i][1], vlo[i][2], vlo[i][3], vhi[i][0], vhi[i][1], vhi[i][2], vhi[i][3]};
                        o[t] = __builtin_amdgcn_mfma_f32_32x32x16_bf16(vf, pw[j], o[t], 0, 0, 0);
                    }
            }
            __builtin_amdgcn_s_setprio(0);
        }
        if (kt + 1 < nt) STORE_TILE((kt + 1) & 1);
        __syncthreads();
    }
#undef LOAD_TILE
#undef STORE_TILE
    const float lt = swap32_sum(l_run);
    const float inv = lt > 0.f ? 1.0f / lt : 0.f;
    const size_t Rq = Rb + q_pp;
    bf16* mrow = (qi != 0) ? A.mixed + ((size_t)b * T + (q_pp - 64)) * DM : A.mixm + (size_t)((q_pp - 48) & 15) * DM;
    if (!DIFF) {
        if (store_ok) {
#pragma unroll
            for (int t = 0; t < NTD; ++t)
#pragma unroll
                for (int g = 0; g < 4; ++g) {
                    const int dv0 = 32 * t + 8 * g + 4 * hi;
                    const u32x2 z = *(const u32x2*)(A.P + Rq * NP + zcol + dv0);
                    u32x2 wv; wv.x = cvtpk(o[t][4 * g] * inv * bf_lo(z.x), o[t][4 * g + 1] * inv * bf_hi(z.x)); wv.y = cvtpk(o[t][4 * g + 2] * inv * bf_lo(z.y), o[t][4 * g + 3] * inv * bf_hi(z.y));
                    *(u32x2*)(mrow + mcol + dv0) = wv;
                }
        }
    } else {
        LAS float* xch = (LAS float*)lds;
        if (comp == 1) {
            const float f = inv * A.lam;
#pragma unroll
            for (int t = 0; t < NTD; ++t)
#pragma unroll
                for (int r = 0; r < 16; ++r) xch[(t * 16 + r) * 256 + wq * 64 + lane] = o[t][r] * f;
        }
        __syncthreads();
        if (comp == 0) {
            float ss = 0.f;
#pragma unroll
            for (int t = 0; t < NTD; ++t)
#pragma unroll
                for (int r = 0; r < 16; ++r) { const float v = o[t][r] * inv - xch[(t * 16 + r) * 256 + wq * 64 + lane]; o[t][r] = v; ss += v * v; }
            ss = swap32_sum(ss);
            const float rn = rsqrtf(ss * (1.0f / 128.0f) + NORM_EPS) * A.one_m_li;
            if (store_ok) {
#pragma unroll
                for (int t = 0; t < NTD; ++t)
#pragma unroll
                    for (int g = 0; g < 4; ++g) {
                        const int dv0 = 32 * t + 8 * g + 4 * hi;
                        const u32x2 z = *(const u32x2*)(A.P + Rq * NP + zcol + dv0);
                        const f32x4 sg = *(const f32x4*)(A.subg + h * 128 + dv0);
                        u32x2 wv; wv.x = cvtpk(o[t][4 * g] * rn * sg[0] * bf_lo(z.x), o[t][4 * g + 1] * rn * sg[1] * bf_hi(z.x));
                        wv.y = cvtpk(o[t][4 * g + 2] * rn * sg[2] * bf_lo(z.y), o[t][4 * g + 3] * rn * sg[3] * bf_hi(z.y));
                        *(u32x2*)(mrow + mcol + dv0) = wv;
                    }
            }
        }
        __syncthreads();
    }
}

__device__ __forceinline__ void attn_phase(Frame& F, int layer, int rep) {
    AttnP A; A.P = F.P; A.mixed = F.mix; A.cumloc = F.cumloc; A.cumtot = F.cumtot; A.subg = F.subln_g + layer * 512; A.nrm = F.ctl + 128 + layer * 128; A.mixm = F.mixm;
    A.lam = F.lam[layer]; A.one_m_li = 1.0f - (0.8f - 0.6f * expf(-0.3f * (float)layer));
    LAS int* cur = (LAS int*)(F.lds + LDS_MISC);
    unsigned* counter = F.ctl + 16 * (layer + 1) + 4 * rep;
    for (;;) {
        if (F.tid == 0) *cur = (int)atomicAdd(counter, 1u);
        __syncthreads();
        const int idx = *cur;
        __syncthreads();
        if (idx >= N_UNITS) break;
        const int u = F.units[layer * N_UNITS + idx];
        if (u < N_DIFF_UNITS) {
#ifndef NO_DIFF
            const int bh = u / 65, qi = u % 65; attn_unit<true>(A, bh >> 2, bh & 3, qi, F.lds);
#endif
        }
#ifndef NO_FOX
        else { const int v = u - N_DIFF_UNITS; const int bh = v / 33, qi = v % 33; attn_unit<false>(A, bh >> 3, bh & 7, qi, F.lds); }
#endif
    }
}

__device__ __forceinline__ void final_phase(Frame& F) {
    const int gw = F.bid * 8 + F.wave, NGW = F.G * 8;
    for (int m = gw; m < NB * T; m += NGW) {
        const float rs = rsqrtf(F.sumsq[2 * MG + m] * (1.0f / DM) + NORM_EPS);
        float* p = F.out + (size_t)m * DM;
#pragma unroll
        for (int j = 0; j < 4; ++j) { const f32x4 v = *(const f32x4*)(p + 4 * F.lane + 256 * j); const f32x4 g = *(const f32x4*)(F.final_g + 4 * F.lane + 256 * j); *(f32x4*)(p + 4 * F.lane + 256 * j) = v * rs * g; }
    }
}

#define XB_TMO      128
#define XB_XCNT(j)  (256  + 64 * (j))
#define XB_XSUB(j)  (1280 + 64 * (j))
#define XB_XGEN(j)  (2304 + 64 * (j))
#define XB_TOP      3328
#define XB_TOPGEN   3392
#define XCD_BAR_WORDS 3456
#define XB_SPIN_CAP (1u << 18)

__device__ __forceinline__ unsigned xb_ld(unsigned* p)              { return __hip_atomic_load(p, __ATOMIC_RELAXED, __HIP_MEMORY_SCOPE_AGENT); }
__device__ __forceinline__ unsigned xb_add(unsigned* p, unsigned v) { return __hip_atomic_fetch_add(p, v, __ATOMIC_RELAXED, __HIP_MEMORY_SCOPE_AGENT); }
__device__ __forceinline__ unsigned xb_xcc_id() { return (unsigned)__builtin_amdgcn_s_getreg((3 << 11) | 20) & 0xFu; }
#define XB_SPIN(cond, bar) do { unsigned _sp = 0; while (cond) { __builtin_amdgcn_s_sleep(1); \
    if ((++_sp & 255u) == 0u) { if (xb_ld(&(bar)[XB_TMO])) break; if (_sp > XB_SPIN_CAP) { atomicAdd(&(bar)[XB_TMO], 1u); break; } } } } while (0)

struct XcdBarrier {
    unsigned* bar; unsigned x;
    volatile LAS unsigned* st;
};

__device__ __forceinline__ XcdBarrier xcd_barrier_post(unsigned* bar, volatile LAS unsigned* st) {
    XcdBarrier b; b.bar = bar; b.x = xb_xcc_id(); b.st = st;
    if (threadIdx.x == 0) (void)xb_add(&bar[XB_XCNT(b.x)], 1u);
    return b;
}
__device__ __forceinline__ void xcd_barrier_complete(unsigned* bar, unsigned x, unsigned& nloc, unsigned& nx) {
    const unsigned G = gridDim.x * gridDim.y * gridDim.z;
    unsigned sum, cnt, mine, sp = 0u;
    for (;;) {
        sum = 0u; cnt = 0u; mine = 0u;
#pragma unroll
        for (unsigned j = 0; j < 16; ++j) { const unsigned c = xb_ld(&bar[XB_XCNT(j)]); sum += c; cnt += (c > 0u) ? 1u : 0u; mine = (j == x) ? c : mine; }
        if (sum == G) break;
        __builtin_amdgcn_s_sleep(1);
        if ((++sp & 255u) == 0u) { if (xb_ld(&bar[XB_TMO])) break; if (sp > XB_SPIN_CAP) { atomicAdd(&bar[XB_TMO], 1u); break; } }
    }
    nloc = mine > 0u ? mine : 1u; nx = cnt > 0u ? cnt : 1u;
}

__device__ __forceinline__ void xcd_barrier(const XcdBarrier& b) {
    asm volatile("s_waitcnt vmcnt(0)" ::: "memory");
    __syncthreads();
    if (threadIdx.x == 0) {
        unsigned* bar = b.bar;
        __builtin_amdgcn_s_waitcnt(0);
        unsigned nloc = b.st[0], nx = b.st[1];
        if (nloc == 0u) { xcd_barrier_complete(bar, b.x, nloc, nx); b.st[0] = nloc; b.st[1] = nx; }
        const unsigned old = xb_add(&bar[XB_XSUB(b.x)], 1u);
        const unsigned gen = old / nloc;
        if (old + 1u == (gen + 1u) * nloc) {
            __builtin_amdgcn_fence(__ATOMIC_RELEASE, "agent");
            asm volatile("s_waitcnt vmcnt(0)" ::: "memory");
            const unsigned og = xb_add(&bar[XB_TOP], 1u);
            const unsigned tg = og / nx;
            if (og + 1u == (tg + 1u) * nx) xb_add(&bar[XB_TOPGEN], 1u);
            else XB_SPIN(xb_ld(&bar[XB_TOPGEN]) == tg, bar);
            __builtin_amdgcn_fence(__ATOMIC_ACQUIRE, "agent");
            xb_add(&bar[XB_XGEN(b.x)], 1u);
            asm volatile("s_waitcnt vmcnt(0)" ::: "memory");
        } else {
            XB_SPIN(xb_ld(&bar[XB_XGEN(b.x)]) == gen, bar);
            __builtin_amdgcn_fence(__ATOMIC_ACQUIRE, "agent");
            asm volatile("s_waitcnt vmcnt(0)" ::: "memory");
        }
    }
    __syncthreads();
}

struct Args { const float* in[12]; float* out; unsigned char* ws; int ph_lo, ph_hi; };
typedef const __attribute__((address_space(4))) Args* kargp;
__device__ __forceinline__ void make_frame(Frame& F, ldsp lds) {
    kargp ap = (kargp)__builtin_amdgcn_kernarg_segment_ptr();
    asm volatile("" : "+s"(ap));
    int tid = threadIdx.x; asm volatile("" : "+v"(tid));
    F.lds = lds; F.tid = tid; F.lane = tid & 63; F.wave = __builtin_amdgcn_readfirstlane(tid >> 6); F.G = gridDim.x; F.bid = blockIdx.x;
    F.x = ap->in[0]; F.meta = ap->in[1]; F.norm_g = ap->in[2]; F.w_in = ap->in[3]; F.b_forget = ap->in[4]; F.lq1 = ap->in[5]; F.lk1 = ap->in[6]; F.lq2 = ap->in[7]; F.lk2 = ap->in[8];
    F.subln_g = ap->in[9]; F.w_out = ap->in[10]; F.final_g = ap->in[11]; F.out = ap->out; F.ws = ap->ws;
    unsigned char* ws = ap->ws;
    F.ctl = (unsigned*)(ws + WS_CTL); F.lam = (float*)(ws + WS_LAM); F.units = (int*)(ws + WS_UNITS); F.sumsq = (float*)(ws + WS_SUMSQ); F.cumtot = (float*)(ws + WS_CUMTOT); F.cumloc = (float*)(ws + WS_CUMLOC);
    F.hside = (float*)(ws + WS_HSIDE); F.rope = (float*)(ws + WS_ROPE); F.win_t = (bf16*)(ws + WS_WIN); F.wout_t = (bf16*)(ws + WS_WOUT); F.hb = (bf16*)(ws + WS_HB); F.mix = (bf16*)(ws + WS_MIX); F.P = (bf16*)(ws + WS_P); F.mixm = (bf16*)(ws + WS_HSIDE + 128 * 1024);
}
__global__ void __launch_bounds__(512) hymba_fwd(Args args) {
    extern __shared__ __attribute__((aligned(16))) unsigned char lds_raw[];
    const ldsp lds = (ldsp)lds_raw;
    const int lo = args.ph_lo, hi = args.ph_hi;
    const bool fuse_final = (lo == 0 && hi == 8 && gridDim.x == 256);
    volatile LAS unsigned* bst = (volatile LAS unsigned*)(lds + LDS_MISC + 128);
    if (threadIdx.x < 2) bst[threadIdx.x] = 0u;
    __syncthreads();
    XcdBarrier xbar; xbar.bar = (unsigned*)(args.ws + WS_BAR); xbar.x = 0; xbar.st = bst;
    if (hi - lo > 1) xbar = xcd_barrier_post((unsigned*)(args.ws + WS_BAR), bst);
    if (lo < 0) cg::this_grid().sync();
#define IN(k) (lo <= (k) && (k) < hi)
#define SEAM(k) do { if (IN(k) && IN((k) + 1)) { xcd_barrier(xbar); } } while (0)
#ifndef REP_PRO
#define REP_PRO 1
#endif
#ifndef REP_IN
#define REP_IN 1
#endif
#ifndef REP_ATTN
#define REP_ATTN 1
#endif
    if (IN(0)) { for (int rep = 0; rep < REP_PRO; ++rep) { Frame F; make_frame(F, lds); p0_prologue(F); if (rep + 1 < REP_PRO) xcd_barrier(xbar); } }
    SEAM(0);
#pragma unroll 1
    for (int layer = 0; layer < 2; ++layer) {
        const int pb = 1 + 3 * layer;
        if (IN(pb)) { for (int rep = 0; rep < REP_IN; ++rep) {
#ifndef NO_FORGET
            { Frame F; make_frame(F, lds); for (int tile = F.bid; tile < MG / 64; tile += F.G) forget_item(F, layer, tile);
              for (int it = F.G - 1 - F.bid; it < 257; it += F.G) meta_item<0>(F, layer, it); }
#endif
#ifndef NO_GIN
            { Frame F; make_frame(F, lds);
              pg8::Gemm g{F.hb, F.win_t + (size_t)layer * NP * DM, MG, NP, DM}; pg8::StaticOrder S; S.init(MG, NP, F.G, F.bid);
              pg8::EpiIn E{F.P, F.sumsq + layer * MG, F.rope, F.ctl + 128 + layer * 128};
              pg8::gemm_phase<pg8::EpiIn, pg8::StaticOrder, true, true>(F.lds, g, S, E); }
#endif
        } }
        SEAM(pb);
        if (IN(pb + 1)) { for (int rep = 0; rep < REP_ATTN; ++rep) { Frame F; make_frame(F, lds); attn_phase(F, layer, rep); } }
        SEAM(pb + 1);
        if (IN(pb + 2)) {
#ifndef NO_GOUT
            Frame F; make_frame(F, lds);
            if (layer == 0) { for (int it = F.bid; it < DM / 16; it += F.G) meta_item<1>(F, layer, it); }
            pg8::Gemm g{F.mix, F.wout_t + (size_t)layer * DM * DM, MG, DM, DM}; pg8::StaticOrder S; S.init(MG, DM, F.G, F.bid);
            if (layer == 1 && fuse_final) {
                pg8::EpiOutFinal E{(const float*)F.out, F.out, F.sumsq + 2 * MG, F.ctl + 448, F.final_g};
                pg8::gemm_phase<pg8::EpiOutFinal, pg8::StaticOrder, true, true>(F.lds, g, S, E);
            } else {
                pg8::EpiOut E{layer == 0 ? F.x : (const float*)F.out, F.out, F.hb, F.sumsq + (layer + 1) * MG, layer == 0 ? 1 : 0};
                pg8::gemm_phase<pg8::EpiOut, pg8::StaticOrder, true, true>(F.lds, g, S, E);
            }
#endif
        }
        if (!(layer == 1 && fuse_final)) SEAM(pb + 2);
    }
    if (IN(7) && !fuse_final) { Frame F; make_frame(F, lds); final_phase(F); }
#undef IN
#undef SEAM
}

extern "C" void kernel_launch(void* const* d_in, const int* in_sizes, int n_in, void* d_out, int out_size, void* d_ws, size_t ws_size, hipStream_t stream) {
    static int grid = 0;
    if (grid == 0) {
        if (n_in != 12 || out_size != NB * T * DM || ws_size < WS_END) { fprintf(stderr, "kernel_launch: unexpected shapes (n_in %d out %d ws %zu)\n", n_in, out_size, ws_size); grid = -1; return; }
        int dev = 0, cus = 0, per_cu = 0;
        (void)hipGetDevice(&dev); (void)hipDeviceGetAttribute(&cus, hipDeviceAttributeMultiprocessorCount, dev);
        if (hipFuncSetAttribute((const void*)hymba_fwd, hipFuncAttributeMaxDynamicSharedMemorySize, LDS_BYTES) != hipSuccess) { fprintf(stderr, "kernel_launch: hipFuncSetAttribute failed\n"); grid = -1; return; }
        if (hipOccupancyMaxActiveBlocksPerMultiprocessor(&per_cu, (const void*)hymba_fwd, 512, LDS_BYTES) != hipSuccess || per_cu < 1) per_cu = 1;
        (void)hipGetLastError();
        grid = cus * per_cu;
        if (grid <= 0) grid = 256;
    }
    if (grid < 0) return;
    Args a{};
    for (int i = 0; i < 12; ++i) a.in[i] = (const float*)d_in[i];
    a.out = (float*)d_out; a.ws = (unsigned char*)d_ws;
#if MK_SINGLE
    (void)hipMemsetAsync((unsigned char*)d_ws + WS_BAR, 0, 16384, stream);
    a.ph_lo = 0; a.ph_hi = 8;
    void* kargs[] = {&a};
    hipError_t e = hipLaunchCooperativeKernel((const void*)hymba_fwd, dim3(grid), dim3(512), kargs, LDS_BYTES, stream);
    if (e != hipSuccess) fprintf(stderr, "cooperative launch failed: %s (grid %d)\n", hipGetErrorString(e), grid);
#else
    for (int p = 0; p < 8; ++p) {
        a.ph_lo = p; a.ph_hi = p + 1;
        hipLaunchKernelGGL(hymba_fwd, dim3(grid), dim3(512), LDS_BYTES, stream, a);
    }
#endif
}
```

```cpp
#include <hip/hip_runtime.h>
#include <hip/hip_cooperative_groups.h>
#include <cstdio>
#include <cstdint>
#include <cmath>
namespace cg = cooperative_groups;

#ifndef MK_SINGLE
#define MK_SINGLE 1
#endif

constexpr int MG = 16384;
constexpr int NB = 2, T = 8192, NMETA = 16, LP = 8256, MV = 2 * LP  , MR = 16640, DM = 1024, NP = 4096, PW = 4104, TPB = LP / 64  , NT64 = MV / 64  ;
constexpr float LOG2E = 1.4426950408889634f;
constexpr float C2 = 0.125f * LOG2E;
constexpr float NORM_EPS = 1e-6f;

__device__ __forceinline__ bool row_valid(int R) { if (R >= MV) return false; const int pp = R >= LP ? R - LP : R; return pp >= 48; }
__device__ __forceinline__ int row_pos(int R) { const int pp = R >= LP ? R - LP : R; return pp - 48; }
__device__ __forceinline__ float* hrow(float* out, float* hside, int R) {
    if (R >= MV) return hside + (size_t)(128 + R - MV) * DM;
    const int b = R >= LP ? 1 : 0, pp = R - b * LP;
    if (pp < 64) return hside + (size_t)(b * 64 + pp) * DM;
    return out + ((size_t)b * T + (pp - 64)) * DM;
}

namespace pg8 {
#define PG8_LAS __attribute__((address_space(3)))
typedef unsigned short bf16_t;
typedef short bf16x8 __attribute__((ext_vector_type(8)));
typedef float f32x4 __attribute__((ext_vector_type(4)));
typedef unsigned u32x4 __attribute__((ext_vector_type(4)));
constexpr int BM = 256, BK = 64, HALF = 128, HTB = HALF * BK * 2  , STAGE_BYTES = 8 * HTB, NXCD = 8, WGM = 8;

__host__ __device__ __forceinline__ int lds_byte(int r, int c) { const int st = (r >> 4) * 2 + (c >> 5), rr = r & 15, cc = c & 31, ob = rr * 64 + cc * 2; return st * 1024 + (ob ^ (((ob >> 9) & 1) << 5)); }
__host__ __device__ __forceinline__ void stage_rc(int b, int& R, int& C) { const int st = b / 1024, sb = b % 1024, swz = sb ^ (((sb >> 9) & 1) << 5); R = (st >> 1) * 16 + swz / 64; C = (st & 1) * 32 + (swz % 64) / 2; }
__host__ __device__ __forceinline__ int perm32(int rho) { const int n = rho >> 4, i = rho & 15; return 8 * (i >> 2) + 4 * n + (i & 3); }

struct Unit { int pm, pn; };
struct Gemm { const bf16_t* A; const bf16_t* Bt; int M, N, K; };

struct StaticOrder {
    int nM, nN, nwg, G, c;
    __host__ __device__ void init(int M, int N, int G_, int c_) { nM = M / BM; nN = N / BM; nwg = nM * nN; G = G_; c = c_; }
    __host__ __device__ bool next(int i, Unit& u) const {
        const long L = (long)i * G + c; if (L >= nwg) return false;
        int wgid = (int)L; { const int q = nwg / NXCD, r = nwg % NXCD, xcd = wgid % NXCD, off = wgid / NXCD; wgid = (xcd < r ? xcd * (q + 1) : r * (q + 1) + (xcd - r) * q) + off; }
        const int nig = WGM * nN, gid = wgid / nig, fm = gid * WGM, gsz = (nM - fm) < WGM ? (nM - fm) : WGM;
        u.pm = fm + ((wgid % nig) % gsz); u.pn = (wgid % nig) / gsz; return true;
    }
    __device__ __forceinline__ void a_ready(const Unit&) const {}
    __device__ __forceinline__ void done(const Unit&) const {}
};


__device__ __forceinline__ unsigned cvt_pk_bf16(float lo, float hi) { unsigned r; asm volatile("v_cvt_pk_bf16_f32 %0, %1, %2" : "=v"(r) : "v"(lo), "v"(hi)); return r; }
typedef unsigned u32x2 __attribute__((ext_vector_type(2)));
struct EpiIn {
    static constexpr bool PERM = true, AFTER_DRAIN = false;
    bf16_t* P; const float* sumsq; const float* rope; unsigned* nrm;
    __device__ __forceinline__ void operator()(const f32x4 (&acc)[2][2][4][2], const Unit& u, int wr, int wc, int fr, int fq) const {
        const int pn = u.pn;
        const int mode = (pn < 4) ? 1 : ((pn == 6 || pn == 7 || pn >= 14) ? 2 : 0);
        const float sc = (pn < 2 || pn == 8 || pn == 9) ? C2 : 1.f;
        const int colb = pn * 256 + wc * 32 + 8 * fq;
        float mxb[2] = {0.f, 0.f};
#pragma unroll
        for (int ai = 0; ai < 2; ++ai)
#pragma unroll
            for (int m = 0; m < 4; ++m) {
                const int row = u.pm * BM + ai * HALF + wr * 64 + m * 16 + fr;
                const float rs = rsqrtf(sumsq[row] * (1.0f / DM) + NORM_EPS) * sc;
                const int bb = row >> 13, tt = row & 8191; const size_t R = (size_t)bb * LP + 64 + tt; const int pos = 16 + tt;
#pragma unroll
                for (int bj = 0; bj < 2; ++bj) {
                    const int col = colb + bj * HALF;
                    f32x4 v0 = acc[ai][bj][m][0] * rs, v1 = acc[ai][bj][m][1] * rs;
                    if (mode == 1) {
                        const int j0 = (col & 63) >> 1;
                        const f32x4* cs = (const f32x4*)(rope + ((size_t)pos * 32 + j0) * 2);
                        const f32x4 a = cs[0], b = cs[1];
                        f32x4 w0, w1;
                        w0[0] = v0[0] * a[0] - v0[1] * a[1]; w0[1] = v0[1] * a[0] + v0[0] * a[1];
                        w0[2] = v0[2] * a[2] - v0[3] * a[3]; w0[3] = v0[3] * a[2] + v0[2] * a[3];
                        w1[0] = v1[0] * b[0] - v1[1] * b[1]; w1[1] = v1[1] * b[0] + v1[0] * b[1];
                        w1[2] = v1[2] * b[2] - v1[3] * b[3]; w1[3] = v1[3] * b[2] + v1[2] * b[3];
                        v0 = w0; v1 = w1;
                    } else if (mode == 2) {
#pragma unroll
                        for (int i = 0; i < 4; ++i) { v0[i] = v0[i] * __builtin_amdgcn_rcpf(1.f + __builtin_amdgcn_exp2f(-v0[i] * LOG2E)); v1[i] = v1[i] * __builtin_amdgcn_rcpf(1.f + __builtin_amdgcn_exp2f(-v1[i] * LOG2E)); }
                    }
                    u32x4 w; w.x = cvt_pk_bf16(v0[0], v0[1]); w.y = cvt_pk_bf16(v0[2], v0[3]); w.z = cvt_pk_bf16(v1[0], v1[1]); w.w = cvt_pk_bf16(v1[2], v1[3]);
                    *(u32x4*)(P + R * NP + col) = w;
                    if (pn >= 8 && pn < 12) { float ss = (v0[0] * v0[0] + v0[1] * v0[1]) + (v0[2] * v0[2] + v0[3] * v0[3]) + (v1[0] * v1[0] + v1[1] * v1[1]) + (v1[2] * v1[2] + v1[3] * v1[3]);
                        ss += __shfl_xor(ss, 16); ss += __shfl_xor(ss, 32); mxb[bj] = fmaxf(mxb[bj], ss); }
                }
            }
        if (pn >= 8 && pn < 12) {
#pragma unroll
            for (int bj = 0; bj < 2; ++bj) { float mx = mxb[bj];
#pragma unroll
                for (int o = 1; o < 16; o <<= 1) mx = fmaxf(mx, __shfl_xor(mx, o));
                if (fr == 0 && fq == 0) atomicMax(nrm + (((pn >= 10) ? 8 : 0) + (pn & 1) * 4 + bj * 2 + (wc >> 1)) * 2 + (wc & 1), __float_as_uint(mx)); }
        }
    }
};
struct EpiOut {
    static constexpr bool PERM = false, AFTER_DRAIN = false;
    const float* base; float* out; bf16_t* hb; float* sumsq_next; int write_hb;
    __device__ __forceinline__ void operator()(const f32x4 (&acc)[2][2][4][2], const Unit& u, int wr, int wc, int fr, int fq) const {
        const int col0 = u.pn * BM + wc * 32 + 4 * fq;
#pragma unroll
        for (int ai = 0; ai < 2; ++ai)
#pragma unroll
            for (int m = 0; m < 4; ++m) {
                const int row = u.pm * BM + ai * HALF + wr * 64 + m * 16 + fr;
                float* hp = out + (size_t)row * DM; const float* bp = base + (size_t)row * DM;
                float ss = 0.f;
#pragma unroll
                for (int bj = 0; bj < 2; ++bj)
#pragma unroll
                    for (int n = 0; n < 2; ++n) {
                        const int c = col0 + bj * HALF + n * 16;
                        const f32x4 hv = *(const f32x4*)(bp + c);
                        f32x4 o = hv + acc[ai][bj][m][n];
                        *(f32x4*)(hp + c) = o;
                        ss += (o[0] * o[0] + o[1] * o[1]) + (o[2] * o[2] + o[3] * o[3]);
                        if (write_hb) { u32x2 w; w.x = cvt_pk_bf16(o[0], o[1]); w.y = cvt_pk_bf16(o[2], o[3]); *(u32x2*)(hb + (size_t)row * DM + c) = w; }
                    }
                ss += __shfl_xor(ss, 16); ss += __shfl_xor(ss, 32);
                if (fq == 0) atomicAdd(sumsq_next + row, ss);
            }
    }
};
struct EpiOutFinal {
    static constexpr bool PERM = false, AFTER_DRAIN = false;
    const float* base; float* out; float* sumsq; unsigned* cnt; const float* fg;
    __device__ __forceinline__ void operator()(f32x4 (&acc)[2][2][4][2], const Unit& u, int wr, int wc, int fr, int fq) const {
        const int col0 = u.pn * BM + wc * 32 + 4 * fq;
#pragma unroll
        for (int ai = 0; ai < 2; ++ai)
#pragma unroll
            for (int m = 0; m < 4; ++m) {
                const int row = u.pm * BM + ai * HALF + wr * 64 + m * 16 + fr;
                const float* bp = base + (size_t)row * DM;
                float ss = 0.f;
#pragma unroll
                for (int bj = 0; bj < 2; ++bj)
#pragma unroll
                    for (int n = 0; n < 2; ++n) {
                        const f32x4 o = *(const f32x4*)(bp + col0 + bj * HALF + n * 16) + acc[ai][bj][m][n];
                        acc[ai][bj][m][n] = o;
                        ss += (o[0] * o[0] + o[1] * o[1]) + (o[2] * o[2] + o[3] * o[3]);
                    }
                ss += __shfl_xor(ss, 16); ss += __shfl_xor(ss, 32);
                if (fq == 0) atomicAdd(sumsq + row, ss);
            }
        asm volatile("s_waitcnt vmcnt(0)" ::: "memory");
        __syncthreads();
        if (threadIdx.x == 0) {
            __hip_atomic_fetch_add(cnt + u.pm, 1u, __ATOMIC_RELAXED, __HIP_MEMORY_SCOPE_AGENT);
            unsigned spins = 0;
            while (__hip_atomic_load(cnt + u.pm, __ATOMIC_RELAXED, __HIP_MEMORY_SCOPE_AGENT) < 4u && ++spins < (1u << 22)) __builtin_amdgcn_s_sleep(1);
        }
        __syncthreads();
#pragma unroll
        for (int ai = 0; ai < 2; ++ai)
#pragma unroll
            for (int m = 0; m < 4; ++m) {
                const int row = u.pm * BM + ai * HALF + wr * 64 + m * 16 + fr;
                const float ssr = __hip_atomic_load(sumsq + row, __ATOMIC_RELAXED, __HIP_MEMORY_SCOPE_AGENT);
                const float r = rsqrtf(ssr * (1.0f / DM) + NORM_EPS);
#pragma unroll
                for (int bj = 0; bj < 2; ++bj)
#pragma unroll
                    for (int n = 0; n < 2; ++n) {
                        const int c = col0 + bj * HALF + n * 16;
                        const f32x4 g = *(const f32x4*)(fg + c);
                        *(f32x4*)(out + (size_t)row * DM + c) = acc[ai][bj][m][n] * r * g;
                    }
            }
    }
};

template <class Epi, class Sched, bool ALIGN_EPI = false, bool SP2 = false>
__device__ __forceinline__ void gemm_phase(PG8_LAS unsigned char* lds, const Gemm g, const Sched& S, const Epi& E) {
    int tid_ = threadIdx.x; asm volatile("" : "+v"(tid_));
    const int tid = tid_, wid = __builtin_amdgcn_readfirstlane(tid >> 6), lane = tid & 63, wr = wid >> 2, wc = wid & 3, fr = lane & 15, fq = lane >> 4;
    const int K = g.K, nt = K / BK;
    unsigned voffA[2], voffB[2];
#pragma unroll
    for (int i = 0; i < 2; ++i) { int R, C; stage_rc(tid * 16 + i * 8192, R, C); const int Rb = Epi::PERM ? ((R & ~31) + perm32(R & 31)) : R;
        voffA[i] = (unsigned)(R * K + C) * 2u; voffB[i] = (unsigned)(Rb * K + C) * 2u; }
    const size_t kstep = (size_t)(BK * 2);
    const size_t hstep = (size_t)HALF * K * 2;
    const size_t tstep = 2 * hstep;
    const unsigned ldsw = (unsigned)wid * 1024u;
    const int aoff = lds_byte(wr * 64 + fr, fq * 8), boff = lds_byte(wc * 32 + fr, fq * 8);
#define PG8_SA(b, h) (((b) * 2 + (h)) * HTB)
#define PG8_SB(b, h) ((4 + (b) * 2 + (h)) * HTB)
#define PG8_STAGE(bufoff, gbase, voff) do { _Pragma("unroll") for (int _i = 0; _i < 2; ++_i) \
        __builtin_amdgcn_global_load_lds((const unsigned*)((const char*)(gbase) + (voff)[_i]), (PG8_LAS unsigned*)(lds + (bufoff) + ldsw + _i * 8192), 16, 0, 0); } while (0)
#define PG8_LDA(dst, b, h) do { _Pragma("unroll") for (int m = 0; m < 4; ++m) _Pragma("unroll") for (int k = 0; k < 2; ++k) dst[m][k] = *(const PG8_LAS bf16x8*)(lds + PG8_SA(b, h) + aoff + m * 2048 + k * 1024); } while (0)
#define PG8_LDB(dst, b, h) do { _Pragma("unroll") for (int n = 0; n < 2; ++n) _Pragma("unroll") for (int k = 0; k < 2; ++k) dst[n][k] = *(const PG8_LAS bf16x8*)(lds + PG8_SB(b, h) + boff + n * 2048 + k * 1024); } while (0)
#define PG8_MMA(ai, bj, At, Bt) do { __builtin_amdgcn_s_setprio(1); _Pragma("unroll") for (int m = 0; m < 4; ++m) _Pragma("unroll") for (int n = 0; n < 2; ++n) _Pragma("unroll") for (int k = 0; k < 2; ++k) \
        acc[ai][bj][m][n] = __builtin_amdgcn_mfma_f32_16x16x32_bf16(Bt[n][k], At[m][k], acc[ai][bj][m][n], 0, 0, 0); __builtin_amdgcn_s_setprio(0); } while (0)
#define PG8_WAIT_V(n) asm volatile("s_waitcnt vmcnt(" #n ")" ::: "memory")
#define PG8_WAIT_L(n) asm volatile("s_waitcnt lgkmcnt(" #n ")" ::: "memory")
#define PG8_BAR __builtin_amdgcn_s_barrier()
#define PG8_SCHED __builtin_amdgcn_sched_barrier(0)
    Unit cur, nxt; int ui = 0;
    if (!S.next(0, cur)) return;
    f32x4 acc[2][2][4][2];
#pragma unroll
    for (int a = 0; a < 2; ++a)
#pragma unroll
        for (int b = 0; b < 2; ++b)
#pragma unroll
            for (int m = 0; m < 4; ++m)
#pragma unroll
                for (int n = 0; n < 2; ++n) acc[a][b][m][n] = (f32x4){0.f, 0.f, 0.f, 0.f};
    bf16x8 At[4][2], B0[2][2], B1[2][2];
    const char* cA = (const char*)g.A + (size_t)cur.pm * tstep; const char* cB = (const char*)g.Bt + (size_t)cur.pn * tstep;
    S.a_ready(cur);
    if constexpr (SP2) {
        PG8_STAGE(PG8_SB(0, 0), cB, voffB); PG8_STAGE(PG8_SB(0, 1), cB + hstep, voffB); PG8_STAGE(PG8_SA(0, 0), cA, voffA); PG8_STAGE(PG8_SA(0, 1), cA + hstep, voffA);
        if (wr == 1) PG8_BAR;
        PG8_WAIT_V(2); PG8_BAR;
        PG8_STAGE(PG8_SB(1, 0), cB + kstep, voffB); PG8_STAGE(PG8_SA(1, 0), cA + kstep, voffA); PG8_STAGE(PG8_SB(1, 1), cB + hstep + kstep, voffB);
        PG8_WAIT_V(6); PG8_BAR;
    } else {
        PG8_STAGE(PG8_SB(0, 0), cB, voffB); PG8_STAGE(PG8_SA(0, 0), cA, voffA); PG8_STAGE(PG8_SB(0, 1), cB + hstep, voffB); PG8_STAGE(PG8_SA(0, 1), cA + hstep, voffA);
        if (wr == 1) PG8_BAR;
        PG8_WAIT_V(4); PG8_BAR;
        PG8_STAGE(PG8_SB(1, 0), cB + kstep, voffB); PG8_STAGE(PG8_SA(1, 0), cA + kstep, voffA); PG8_STAGE(PG8_SB(1, 1), cB + hstep + kstep, voffB);
        PG8_WAIT_V(6); PG8_BAR;
    }
    for (;;) {
        const bool has_next = S.next(ui + 1, nxt);
        const char* nA = has_next ? (const char*)g.A + (size_t)nxt.pm * tstep : cA; const char* nB = has_next ? (const char*)g.Bt + (size_t)nxt.pn * tstep : cB;
        for (int t = 0; t < nt; t += 2) {
            const bool last = (t == nt - 2);
            const char* a1 = cA + (size_t)(t + 1) * kstep;
            const char* a2 = last ? nA : cA + (size_t)(t + 2) * kstep; const char* b2 = last ? nB : cB + (size_t)(t + 2) * kstep;
            const char* a3 = a2 + kstep; const char* b3 = b2 + kstep;
            if (last && has_next) S.a_ready(nxt);
            if constexpr (SP2) {
            PG8_LDB(B0, 0, 0); PG8_LDB(B1, 0, 1); PG8_SCHED; PG8_LDA(At, 0, 0); PG8_STAGE(PG8_SA(1, 1), a1 + hstep, voffA);
            PG8_WAIT_V(8); PG8_WAIT_L(0); PG8_BAR; PG8_MMA(0, 0, At, B0); PG8_MMA(0, 1, At, B1); PG8_BAR; PG8_SCHED;
            PG8_LDA(At, 0, 1); PG8_STAGE(PG8_SB(0, 0), b2, voffB); PG8_STAGE(PG8_SB(0, 1), b2 + hstep, voffB); PG8_STAGE(PG8_SA(0, 0), a2, voffA);
            PG8_WAIT_V(8); PG8_WAIT_L(0); PG8_BAR; PG8_MMA(1, 0, At, B0); PG8_MMA(1, 1, At, B1); PG8_BAR; PG8_SCHED;
            PG8_LDB(B0, 1, 0); PG8_LDB(B1, 1, 1); PG8_SCHED; PG8_LDA(At, 1, 0); PG8_STAGE(PG8_SA(0, 1), a2 + hstep, voffA);
            PG8_WAIT_V(8); PG8_WAIT_L(0); PG8_BAR; PG8_MMA(0, 0, At, B0); PG8_MMA(0, 1, At, B1); PG8_BAR; PG8_SCHED;
            PG8_LDA(At, 1, 1); PG8_STAGE(PG8_SB(1, 0), b3, voffB); PG8_STAGE(PG8_SB(1, 1), b3 + hstep, voffB); PG8_STAGE(PG8_SA(1, 0), a3, voffA);
            PG8_WAIT_V(8); PG8_WAIT_L(0); PG8_BAR; PG8_MMA(1, 0, At, B0); PG8_MMA(1, 1, At, B1); PG8_BAR; PG8_SCHED;
            } else {
            PG8_LDB(B0, 0, 0); PG8_SCHED; PG8_LDA(At, 0, 0); PG8_STAGE(PG8_SA(1, 1), a1 + hstep, voffA);
            PG8_WAIT_L(8); PG8_BAR; PG8_WAIT_L(0); PG8_MMA(0, 0, At, B0); PG8_BAR; PG8_SCHED;
            PG8_LDB(B1, 0, 1); PG8_STAGE(PG8_SB(0, 0), b2, voffB);
            PG8_BAR; PG8_WAIT_L(0); PG8_MMA(0, 1, At, B1); PG8_BAR;
            PG8_LDA(At, 0, 1); PG8_STAGE(PG8_SA(0, 0), a2, voffA);
            PG8_BAR; PG8_WAIT_L(0); PG8_MMA(1, 0, At, B0); PG8_BAR; PG8_SCHED;
            PG8_STAGE(PG8_SB(0, 1), b2 + hstep, voffB);
            PG8_WAIT_V(6); PG8_BAR; PG8_MMA(1, 1, At, B1); PG8_BAR;
            PG8_LDB(B0, 1, 0); PG8_SCHED; PG8_LDA(At, 1, 0); PG8_STAGE(PG8_SA(0, 1), a2 + hstep, voffA);
            PG8_WAIT_L(8); PG8_BAR; PG8_WAIT_L(0); PG8_MMA(0, 0, At, B0); PG8_BAR; PG8_SCHED;
            PG8_LDB(B1, 1, 1); PG8_STAGE(PG8_SB(1, 0), b3, voffB);
            PG8_BAR; PG8_WAIT_L(0); PG8_MMA(0, 1, At, B1); PG8_BAR;
            PG8_LDA(At, 1, 1); PG8_STAGE(PG8_SA(1, 0), a3, voffA);
            PG8_BAR; PG8_WAIT_L(0); PG8_MMA(1, 0, At, B0); PG8_BAR; PG8_SCHED;
            PG8_STAGE(PG8_SB(1, 1), b3 + hstep, voffB);
            PG8_WAIT_V(6); PG8_BAR; PG8_MMA(1, 1, At, B1); PG8_BAR;
            }
        }
        if constexpr (ALIGN_EPI) { if (wr == 0) PG8_BAR; }
        if constexpr (!Epi::AFTER_DRAIN) { E(acc, cur, wr, wc, fr, fq); S.done(cur); }
        if (!has_next) break;
#pragma unroll
        for (int a = 0; a < 2; ++a)
#pragma unroll
            for (int b = 0; b < 2; ++b)
#pragma unroll
                for (int m = 0; m < 4; ++m)
#pragma unroll
                    for (int n = 0; n < 2; ++n) acc[a][b][m][n] = (f32x4){0.f, 0.f, 0.f, 0.f};
        cur = nxt; cA = nA; cB = nB; ++ui;
        if constexpr (ALIGN_EPI) { if (wr == 1) PG8_BAR; }
    }
    PG8_WAIT_V(0);
    if constexpr (!ALIGN_EPI) { if (wr == 0) PG8_BAR; }
    PG8_BAR;
    if constexpr (Epi::AFTER_DRAIN) { E.fused(acc, cur, wr, wc, fr, fq, lds, wid, lane); S.done(cur); }
#undef PG8_SA
#undef PG8_SB
#undef PG8_STAGE
#undef PG8_LDA
#undef PG8_LDB
#undef PG8_MMA
#undef PG8_WAIT_V
#undef PG8_WAIT_L
#undef PG8_BAR
#undef PG8_SCHED
}
}

#define LAS __attribute__((address_space(3)))
typedef LAS unsigned char* ldsp;
typedef unsigned short bf16;
typedef short bf16x8 __attribute__((ext_vector_type(8)));
typedef short s16x4 __attribute__((ext_vector_type(4)));
typedef float f32x16 __attribute__((ext_vector_type(16)));
typedef float f32x4 __attribute__((ext_vector_type(4)));
typedef float f32x2 __attribute__((ext_vector_type(2)));
typedef unsigned u32x4 __attribute__((ext_vector_type(4)));
typedef unsigned u32x2 __attribute__((ext_vector_type(2)));
typedef __bf16 bf16x2_t __attribute__((ext_vector_type(2)));
__device__ __forceinline__ unsigned cvtpk(float lo, float hi) { f32x2 v = {lo, hi}; bf16x2_t b = __builtin_convertvector(v, bf16x2_t); return __builtin_bit_cast(unsigned, b); }
__device__ __forceinline__ float bf_lo(unsigned u) { return __uint_as_float(u << 16); }
__device__ __forceinline__ float bf_hi(unsigned u) { return __uint_as_float(u & 0xffff0000u); }
__device__ __forceinline__ float swap32_max(float m) { auto rr = __builtin_amdgcn_permlane32_swap(__float_as_uint(m), __float_as_uint(m), false, false); return fmaxf(__uint_as_float(rr[0]), __uint_as_float(rr[1])); }
__device__ __forceinline__ float swap32_sum(float m) { auto rr = __builtin_amdgcn_permlane32_swap(__float_as_uint(m), __float_as_uint(m), false, false); return __uint_as_float(rr[0]) + __uint_as_float(rr[1]); }
__device__ __forceinline__ int crow(int r, int hi) { return (r & 3) + 8 * (r >> 2) + 4 * hi; }
typedef short v4i16_t __attribute__((ext_vector_type(4)));
__device__ __forceinline__ s16x4 vtr(ldsp p) { return __builtin_bit_cast(s16x4, __builtin_amdgcn_ds_read_tr16_b64_v4i16((LAS v4i16_t*)p)); }
__device__ __forceinline__ float wave_sum(float v) {
#pragma unroll
    for (int o = 1; o < 64; o <<= 1) v += __shfl_xor(v, o);
    return v;
}

constexpr size_t MiB = 1u << 20;
constexpr size_t WS_CTL = 0;
constexpr size_t WS_LAM = 4096;
constexpr size_t WS_UNITS = 8192;
constexpr size_t WS_BAR = 32 * 1024;
constexpr size_t WS_SUMSQ = 64 * 1024;
constexpr size_t WS_CUMTOT = 512 * 1024;
constexpr size_t WS_CUMLOC = 1 * MiB;
constexpr size_t WS_HSIDE = 2 * MiB;
constexpr size_t WS_ROPE = 3 * MiB;
constexpr size_t WS_WIN = 6 * MiB;
constexpr size_t WS_WOUT = 22 * MiB;
constexpr size_t WS_HB = 26 * MiB;
constexpr size_t WS_MIX = 59 * MiB;
constexpr size_t WS_P = 92 * MiB;
constexpr size_t WS_END = 223 * MiB;
static_assert(WS_HB + (size_t)MR * DM * 2 <= WS_MIX && WS_MIX + (size_t)MR * DM * 2 <= WS_P && WS_P + (size_t)MR * NP * 2 <= WS_END, "ws map");
constexpr int N_DIFF_UNITS = 8 * 65, N_FOX_UNITS = 16 * 33, N_UNITS = N_DIFF_UNITS + N_FOX_UNITS;

constexpr int LDS_BYTES = 147456;
constexpr int LDS_PREF = 132 * 1024, LDS_MISC = 133 * 1024;

struct Frame {
    const float *x, *meta, *norm_g, *w_in, *b_forget, *lq1, *lk1, *lq2, *lk2, *subln_g, *w_out, *final_g;
    float* out; unsigned char* ws;
    unsigned* ctl; float* lam; int* units; float* sumsq; float* cumtot; float* cumloc; float* hside; float* rope;
    bf16 *win_t, *wout_t, *hb, *mix, *P, *mixm;
    ldsp lds; int tid, lane, wave, G, bid;
};

__device__ __forceinline__ unsigned f2bf(float f) { unsigned u = __float_as_uint(f); return (u + 0x7fffu + ((u >> 16) & 1u)) >> 16; }
__device__ __forceinline__ unsigned pk2(float lo, float hi) { return f2bf(lo) | (f2bf(hi) << 16); }
__device__ __forceinline__ void transpose_item(const float* W, int ldw, bool ropemap, const float* g, bf16* WT, int nN, LAS float* scr, int item, int lane) {
    const int nblk = nN / 32, kb = item / nblk, nb = item % nblk, k0 = 64 * kb, n0 = 32 * nb;
    const int n = n0 + (lane & 31);
    int col = n; if (ropemap && n < 1024) { const int p = n & 63; col = (n & ~63) + (p >> 1) + 32 * (p & 1); }
    float wv_[32];
#pragma unroll
    for (int i = 0; i < 32; ++i) { const int kk = 2 * i + (lane >> 5); wv_[i] = W[(size_t)(k0 + kk) * ldw + col]; }
#pragma unroll
    for (int i = 0; i < 32; ++i) { const int kk = 2 * i + (lane >> 5); const float gv = g ? g[k0 + kk] : 1.f; scr[kk * 33 + (lane & 31)] = wv_[i] * gv; }
    asm volatile("s_waitcnt lgkmcnt(0)" ::: "memory");
    const int c = lane & 7;
#pragma unroll
    for (int j = 0; j < 4; ++j) { const int nn = (lane >> 3) + 8 * j; const LAS float* s = scr + (8 * c) * 33 + nn;
        u32x4 o; o.x = pk2(s[0 * 33], s[1 * 33]); o.y = pk2(s[2 * 33], s[3 * 33]); o.z = pk2(s[4 * 33], s[5 * 33]); o.w = pk2(s[6 * 33], s[7 * 33]);
        *(u32x4*)(WT + (size_t)(n0 + nn) * DM + k0 + 8 * c) = o; }
    asm volatile("s_waitcnt lgkmcnt(0)" ::: "memory");
}
__device__ __forceinline__ int unit_cost(int u, const float* bfg) {
    if (u < N_DIFF_UNITS) { const int qi = u % 65; return (qi == 0 ? 1 : 1 + 2 * qi) * 4; }
    const int v = u - N_DIFF_UNITS, qi = v % 33, h = (v / 33) & 7;
    const float rate = 1.44f * 1.65f * log1pf(expf(-bfg[h]));
    const int wt = 6 + (int)(95.0f / (64.0f * rate));
    const int full = (qi == 0 ? 1 : 1 + 4 * qi);
    return (full < wt ? full : wt) * 3;
}
__device__ __forceinline__ void p0_prologue(Frame& F) {
    const int gw = F.bid * 8 + F.wave, NGW = F.G * 8, gt = F.bid * 512 + F.tid, NGT = F.G * 512;
    LAS float* scr = (LAS float*)(F.lds + F.wave * 16384);
    constexpr int I_IN = 16 * (NP / 32), I_OUT = 16 * (DM / 32);
    for (int it = gw; it < 2 * (I_IN + I_OUT); it += NGW) {
        int r = it; const int l = r / (I_IN + I_OUT); r -= l * (I_IN + I_OUT);
        if (r < I_IN) transpose_item(F.w_in + (size_t)l * DM * PW, PW, true, F.norm_g + l * DM, F.win_t + (size_t)l * NP * DM, NP, scr, r, F.lane);
        else transpose_item(F.w_out + (size_t)l * DM * DM, DM, false, nullptr, F.wout_t + (size_t)l * DM * DM, DM, scr, r - I_IN, F.lane);
    }
    for (int m0 = gw * 4; m0 < MG; m0 += NGW * 4) {
        f32x4 v[4][4];
#pragma unroll
        for (int q = 0; q < 4; ++q)
#pragma unroll
            for (int j = 0; j < 4; ++j) v[q][j] = *(const f32x4*)(F.x + (size_t)(m0 + q) * DM + 4 * F.lane + 256 * j);
#pragma unroll
        for (int q = 0; q < 4; ++q) {
            const int m = m0 + q; float ss = 0.f;
#pragma unroll
            for (int j = 0; j < 4; ++j) {
                u32x2 w; w.x = pk2(v[q][j][0], v[q][j][1]); w.y = pk2(v[q][j][2], v[q][j][3]);
                *(u32x2*)(F.hb + (size_t)m * DM + 4 * F.lane + 256 * j) = w;
                ss += (v[q][j][0] * v[q][j][0] + v[q][j][1] * v[q][j][1]) + (v[q][j][2] * v[q][j][2] + v[q][j][3] * v[q][j][3]);
            }
            ss = wave_sum(ss);
            if (F.lane == 0) { F.sumsq[m] = ss; F.sumsq[MG + m] = 0.f; F.sumsq[2 * MG + m] = 0.f; }
        }
    }
    for (int i = gt; i < NMETA * DM; i += NGT) F.hside[i] = F.meta[i];
    for (int i = gt; i < 2 * 48 * (NP / 8); i += NGT) { const int rr = i / (NP / 8), c8 = i % (NP / 8); const int R = (rr / 48) * LP + (rr % 48);
        *(u32x4*)(F.P + (size_t)R * NP + c8 * 8) = (u32x4){0u, 0u, 0u, 0u}; }
    for (int i = gt; i < 8208 * 32; i += NGT) {
        const int pos = i >> 5, j = i & 31;
        const double inv = exp2(-(double)j * (13.287712379549449 / 32.0));
        const double ang = (double)pos * inv;
        double s, c; sincos(ang, &s, &c);
        F.rope[2 * i] = (float)c; F.rope[2 * i + 1] = (float)s;
    }
    if (F.bid == 0) {
        F.ctl[F.tid] = 0u;
        if (F.tid < 2) {
            const int l = F.tid; float s1 = 0.f, s2 = 0.f;
            for (int i = 0; i < 64; ++i) { s1 += F.lq1[l * 64 + i] * F.lk1[l * 64 + i]; s2 += F.lq2[l * 64 + i] * F.lk2[l * 64 + i]; }
            const float li = 0.8f - 0.6f * expf(-0.3f * (float)l);
            F.lam[l] = expf(s1) - expf(s2) + li;
        }
    }
    for (int ul = gw; ul < 2 * N_UNITS; ul += NGW) {
        const int l = ul / N_UNITS, u = ul - l * N_UNITS; const float* bfg = F.b_forget + l * 8;
        const int cu = unit_cost(u, bfg); int cnt = 0;
        for (int v = F.lane; v < N_UNITS; v += 64) { const int cv = unit_cost(v, bfg); cnt += (cv > cu || (cv == cu && v < u)) ? 1 : 0; }
#pragma unroll
        for (int o = 1; o < 64; o <<= 1) cnt += __shfl_xor(cnt, o);
        if (F.lane == 0) F.units[l * N_UNITS + cnt] = u;
    }
}

__device__ __forceinline__ void forget_item(Frame& F, int layer, int tile) {
    const float* W = F.w_in + (size_t)layer * DM * PW + 4096; const float* g = F.norm_g + layer * DM; const float* bfg = F.b_forget + layer * 8;
    ldsp wl = F.lds;
    LAS float* lf = (LAS float*)(F.lds + 40960);
#pragma unroll
    for (int q = 0; q < 2; ++q) { const int kk = F.tid + 512 * q; const float gv = g[kk];
        const f32x4 a = *(const f32x4*)(W + (size_t)kk * PW) * gv, b = *(const f32x4*)(W + (size_t)kk * PW + 4) * gv;
        *(LAS f32x4*)(wl + (kk >> 2) * 144 + (kk & 3) * 32) = a; *(LAS f32x4*)(wl + (kk >> 2) * 144 + (kk & 3) * 32 + 16) = b; }
    __syncthreads();
    const int row_l = F.tid >> 3, kp = F.tid & 7;
    const int fb = tile >> 7, fj = tile & 127; const size_t R0 = (size_t)fb * LP + 64 + 64 * fj;
    const float* xp = (layer == 0 ? F.x : (const float*)F.out) + ((size_t)tile * 64 + row_l) * DM;
    float acc[8] = {0.f, 0.f, 0.f, 0.f, 0.f, 0.f, 0.f, 0.f}; float ss = 0.f;
#pragma unroll 1
    for (int bt = 0; bt < 4; ++bt) {
        f32x4 xv[8];
#pragma unroll
        for (int i = 0; i < 8; ++i) xv[i] = *(const f32x4*)(xp + 4 * (kp + 8 * (bt * 8 + i)));
#pragma unroll
        for (int i = 0; i < 8; ++i) { ldsp wg = wl + (kp + 8 * (bt * 8 + i)) * 144;
#pragma unroll
            for (int e = 0; e < 4; ++e) { const float xe = xv[i][e]; ss += xe * xe;
                const f32x4 wa = *(LAS f32x4*)(wg + e * 32), wb = *(LAS f32x4*)(wg + e * 32 + 16);
                acc[0] += xe * wa[0]; acc[1] += xe * wa[1]; acc[2] += xe * wa[2]; acc[3] += xe * wa[3];
                acc[4] += xe * wb[0]; acc[5] += xe * wb[1]; acc[6] += xe * wb[2]; acc[7] += xe * wb[3]; } }
    }
#pragma unroll
    for (int o = 1; o < 8; o <<= 1) { ss += __shfl_xor(ss, o);
#pragma unroll
        for (int j = 0; j < 8; ++j) acc[j] += __shfl_xor(acc[j], o); }
    float mine = acc[0];
#pragma unroll
    for (int j = 1; j < 8; ++j) mine = (kp == j) ? acc[j] : mine;
    {
        const float xl = mine * rsqrtf(ss * (1.0f / DM) + NORM_EPS) + bfg[kp];
        float v = fminf(xl, 0.f) - log1pf(expf(-fabsf(xl)));
        lf[row_l * 8 + kp] = v;
    }
    __syncthreads();
    if (F.wave == 0) {
        const int seg = F.lane >> 3, j = F.lane & 7;
        float vals[8]; float run = 0.f;
#pragma unroll
        for (int i = 0; i < 8; ++i) { run += lf[(seg * 8 + i) * 8 + j]; vals[i] = run; }
        float inc = run;
#pragma unroll
        for (int o = 8; o < 64; o <<= 1) { const float t_ = __shfl_up(inc, o); if (F.lane >= o) inc += t_; }
        const float excl = inc - run;
#pragma unroll
        for (int i = 0; i < 8; ++i) F.cumloc[(R0 + seg * 8 + i) * 8 + j] = (excl + vals[i]) * LOG2E;
        if (seg == 7) F.cumtot[(fb * TPB + 1 + fj) * 8 + j] = inc * LOG2E;
    }
    __syncthreads();
}

template <int MODE>
__device__ __forceinline__ void meta_item(Frame& F, int layer, int item) {
    LAS float* xT = (LAS float*)(F.lds);
    LAS float* red = (LAS float*)(F.lds + 65536);
    LAS float* rr = (LAS float*)(F.lds + 98304);
    LAS float* lfm = (LAS float*)(F.lds + 98304 + 256);
    const float* W = MODE == 0 ? F.w_in + (size_t)layer * DM * PW : F.w_out + (size_t)layer * DM * DM;
    const int ldw = MODE == 0 ? PW : DM;
    const float* g = F.norm_g + layer * DM;
    for (int idx = F.tid; idx < NMETA * DM; idx += 512) { const int row = idx >> 10, k = idx & 1023;
        float v; if (MODE == 0) v = F.hside[idx]; else v = __uint_as_float((unsigned)F.mixm[idx] << 16);
        xT[k * 16 + row] = v; }
    __syncthreads();
    if (MODE == 0) {
        const int row = F.tid >> 5, l32 = F.tid & 31; float ss = 0.f;
#pragma unroll 8
        for (int i = 0; i < 32; ++i) { const float v = xT[(l32 + 32 * i) * 16 + row]; ss += v * v; }
#pragma unroll
        for (int o = 1; o < 32; o <<= 1) ss += __shfl_xor(ss, o);
        if (l32 == 0) rr[row] = rsqrtf(ss * (1.0f / DM) + NORM_EPS);
    }
    const int c = F.tid & 15, ks = F.tid >> 4;
    const int n = item * 16 + c;
    int col = n; bool colok = true;
    if (MODE == 0) { if (n < 1024) { const int p = n & 63; col = (n & ~63) + (p >> 1) + 32 * (p & 1); } colok = n < PW; if (!colok) col = 0; }
    float acc[16];
#pragma unroll
    for (int r = 0; r < 16; ++r) acc[r] = 0.f;
#pragma unroll 1
    for (int k8 = 0; k8 < 4; ++k8) {
        float wv[8];
#pragma unroll
        for (int i = 0; i < 8; ++i) { const int k = ks * 32 + k8 * 8 + i; wv[i] = W[(size_t)k * ldw + col] * (MODE == 0 ? g[k] : 1.f); }
#pragma unroll
        for (int i = 0; i < 8; ++i) { const int k = ks * 32 + k8 * 8 + i;
#pragma unroll
            for (int q = 0; q < 4; ++q) { const f32x4 xv = *(LAS f32x4*)(xT + k * 16 + 4 * q);
                acc[4 * q] += wv[i] * xv[0]; acc[4 * q + 1] += wv[i] * xv[1]; acc[4 * q + 2] += wv[i] * xv[2]; acc[4 * q + 3] += wv[i] * xv[3]; } }
    }
#pragma unroll
    for (int r = 0; r < 16; ++r) red[(ks * 16 + r) * 16 + c] = colok ? acc[r] : 0.f;
    __syncthreads();
    if (F.tid < 256) {
        const int r = F.tid >> 4;
        float v = 0.f;
#pragma unroll 8
        for (int s_ = 0; s_ < 32; ++s_) v += red[(s_ * 16 + r) * 16 + c];
        if (MODE == 1) { F.hside[r * DM + n] += v; }
        else {
            v *= rr[r];
            if (item < 256) {
                const int pn = n >> 8;
                const int mode = (pn < 4) ? 1 : ((pn == 6 || pn == 7 || pn >= 14) ? 2 : 0);
                if (pn < 2 || pn == 8 || pn == 9) v *= C2;
                const float partner = __shfl_xor(v, 1);
                if (mode == 1) { const int j = (n & 63) >> 1; const float cs = F.rope[(r * 32 + j) * 2], sn = F.rope[(r * 32 + j) * 2 + 1];
                    v = (n & 1) ? (v * cs + partner * sn) : (v * cs - partner * sn); }
                else if (mode == 2) v = v * __builtin_amdgcn_rcpf(1.f + __builtin_amdgcn_exp2f(-v * LOG2E));
                const bf16 o = (bf16)f2bf(v);
                F.P[((size_t)48 + r) * NP + n] = o; F.P[((size_t)LP + 48 + r) * NP + n] = o;
                if (pn == 10 || pn == 11) {
                    float ss = v * v;
#pragma unroll
                    for (int o2 = 1; o2 < 16; o2 <<= 1) ss += __shfl_xor(ss, o2);
                    if (c == 0) atomicMax(F.ctl + 128 + layer * 128 + 32 + ((n - 2560) >> 4), __float_as_uint(ss));
                }
            } else if (c < 8) {
                const float xl = v + F.b_forget[layer * 8 + c];
                lfm[r * 8 + c] = fminf(xl, 0.f) - log1pf(expf(-fabsf(xl)));
            }
        }
    }
    __syncthreads();
    if (MODE == 0 && item == 256 && F.tid < 8) {
        float run = 0.f;
        for (int pp = 0; pp < 64; ++pp) { if (pp >= 48) run += lfm[(pp - 48) * 8 + F.tid];
            F.cumloc[(size_t)pp * 8 + F.tid] = run * LOG2E; F.cumloc[((size_t)LP + pp) * 8 + F.tid] = run * LOG2E; }
        F.cumtot[F.tid] = run * LOG2E; F.cumtot[TPB * 8 + F.tid] = run * LOG2E;
    }
    __syncthreads();
}

__device__ __forceinline__ void split3(float x, unsigned& h, unsigned& m, unsigned& l) {
    h = cvtpk(x, 0.f) & 0xffffu; const float r1 = x - __uint_as_float(h << 16);
    m = cvtpk(r1, 0.f) & 0xffffu; const float r2 = r1 - __uint_as_float(m << 16);
    l = cvtpk(r2, 0.f) & 0xffffu;
}
struct AttnP { const bf16* P; bf16* mixed; const float* cumloc; const float* cumtot; const float* subg; const unsigned* nrm; bf16* mixm; float lam; float one_m_li; };

template <bool DIFF>
__device__ __forceinline__ void attn_unit(const AttnP& A, int b, int h, int qi, ldsp lds) {
    constexpr int DV = DIFF ? 128 : 64, NTD = DV / 32, KP = DIFF ? 272 : 144, VP = DIFF ? 320 : 192, QROWS = DIFF ? 128 : 256, TPQ = QROWS / 64;
    constexpr int STAGE = 64 * KP + 64 * VP + 256, NPIECE = DIFF ? 2 : 1;
    int tid_ = threadIdx.x; asm volatile("" : "+v"(tid_));
    const int tid = tid_, lane = tid & 63, w = __builtin_amdgcn_readfirstlane(tid >> 6), r32 = lane & 31, hi = lane >> 5;
    const int comp = DIFF ? (w >> 2) : 0, wq = DIFF ? (w & 3) : w;
    const int qstart = qi == 0 ? 0 : 64 + QROWS * (qi - 1);
    const int nt = qi == 0 ? 1 : 1 + TPQ * qi;
    const int diag0 = qi == 0 ? 0 : nt - TPQ;
    const int q_pp = qstart + 32 * wq + r32, qmax_w = qstart + 32 * wq + 31;
    const bool store_ok = (qi != 0) || (b == 0 && q_pp >= 48 && q_pp < 64);
    const size_t Rb = (size_t)b * LP;
    const int qcol = DIFF ? h * 128 + comp * 64 : 2048 + h * 64;
    const int kcol = DIFF ? 512 + h * 128 : 2560 + h * 64;
    const int vcol = DIFF ? 1024 + h * 128 : 3072 + h * 64;
    const int zcol = DIFF ? 1536 + h * 128 : 3584 + h * 64;
    const int mcol = DIFF ? h * 128 : 512 + h * 64;
    const bf16* Pq = A.P + (Rb + q_pp) * NP;
    bf16x8 qf[4];
#pragma unroll
    for (int c = 0; c < 4; ++c) qf[c] = *(const bf16x8*)(Pq + qcol + 16 * c + 8 * hi);
    LAS float* pref = (LAS float*)(lds + LDS_PREF);
    u32x4 kreg[NPIECE], vreg[NPIECE]; float clreg = 0.f;
#define LOAD_TILE(kt) do { const bf16* base_ = A.P + (Rb + 64 * (size_t)(kt)) * NP; \
        _Pragma("unroll") for (int i_ = 0; i_ < NPIECE; ++i_) { const int p_ = tid + 512 * i_; const int row_ = DIFF ? (p_ >> 4) : (p_ >> 3); const int c16_ = DIFF ? (p_ & 15) : (p_ & 7); \
            kreg[i_] = *(const u32x4*)(base_ + (size_t)row_ * NP + kcol + c16_ * 8); vreg[i_] = *(const u32x4*)(base_ + (size_t)row_ * NP + vcol + c16_ * 8); } \
        if (!DIFF && tid < 64) clreg = A.cumloc[(Rb + 64 * (size_t)(kt) + tid) * 8 + h]; } while (0)
#define STORE_TILE(st) do { ldsp sb_ = lds + (st) * STAGE; \
        _Pragma("unroll") for (int i_ = 0; i_ < NPIECE; ++i_) { const int p_ = tid + 512 * i_; const int row_ = DIFF ? (p_ >> 4) : (p_ >> 3); const int c16_ = DIFF ? (p_ & 15) : (p_ & 7); \
            *(LAS u32x4*)(sb_ + row_ * KP + c16_ * 16) = kreg[i_]; *(LAS u32x4*)(sb_ + 64 * KP + row_ * VP + c16_ * 16) = vreg[i_]; } \
        if (!DIFF && tid < 64) { unsigned h_, m_, l_; split3(-clreg, h_, m_, l_); *(LAS u32x4*)(sb_ + tid * KP + 128) = (u32x4){h_ | (m_ << 16), l_ | 0x3f800000u, 0x3f803f80u, 0u}; } } while (0)
    int kt0 = 0;
    if (!DIFF) {
        LAS int* kst = (LAS int*)(lds + LDS_MISC + 64);
        if (tid == 0) *kst = nt - 1;
        if (w == 0) {
            float carry = 0.f;
#pragma unroll
            for (int ch = 0; ch < 3; ++ch) {
                const int idx = ch * 64 + lane;
                const float v = idx < TPB ? A.cumtot[(b * TPB + idx) * 8 + h] : 0.f;
                float inc = v;
#pragma unroll
                for (int o = 1; o < 64; o <<= 1) { const float t_ = __shfl_up(inc, o); if (lane >= o) inc += t_; }
                if (idx < TPB) pref[idx] = carry + inc - v;
                if (idx == TPB - 1) pref[TPB] = carry + inc;
                carry += __shfl(inc, 63);
            }
        }
        __syncthreads();
        const float q2 = __uint_as_float(A.nrm[(h) * 2]) + __uint_as_float(A.nrm[(h) * 2 + 1]), k2r = __uint_as_float(A.nrm[(8 + h) * 2]) + __uint_as_float(A.nrm[(8 + h) * 2 + 1]),
                    k2m = (__uint_as_float(A.nrm[32 + h * 4]) + __uint_as_float(A.nrm[32 + h * 4 + 1])) + (__uint_as_float(A.nrm[32 + h * 4 + 2]) + __uint_as_float(A.nrm[32 + h * 4 + 3])), k2 = fmaxf(k2r, k2m);
        const float thr = 2.0f * 1.03f * sqrtf(q2 * k2) + 40.0f;
        if (tid < nt) { if (pref[qstart >> 6] - pref[tid + 1] >= -thr) atomicMin((int*)kst, tid); }
        __syncthreads();
        kt0 = *kst;
    }
    LOAD_TILE(kt0);
    STORE_TILE(kt0 & 1);
    __syncthreads();
    float cq = 0.f;
    if (!DIFF) cq = pref[q_pp >> 6] + A.cumloc[(Rb + q_pp) * 8 + h];
    float mhat = 0.f, l_run = 0.f;
    f32x16 negm;
#pragma unroll
    for (int r = 0; r < 16; ++r) negm[r] = 0.f;
    f32x16 o[NTD];
#pragma unroll
    for (int t = 0; t < NTD; ++t)
#pragma unroll
        for (int r = 0; r < 16; ++r) o[t][r] = 0.f;
    const int trb = (4 * hi + ((lane & 15) >> 2)) * VP + ((lane >> 4) & 1) * 32 + (lane & 3) * 8;
    for (int kt = kt0; kt < nt; ++kt) {
        if (kt + 1 < nt) LOAD_TILE(kt + 1);
        if (64 * kt <= qmax_w) {
            ldsp Kb = lds + (kt & 1) * STAGE; ldsp Vb = Kb + 64 * KP;
            bf16x8 kf[8]; bf16x8 ka0, ka1, qa; f32x16 s0, s1;
#define QK_BLOCK() do { \
            _Pragma("unroll") for (int c = 0; c < 4; ++c) { \
                kf[2 * c] = *(LAS bf16x8*)(Kb + r32 * KP + comp * 128 + c * 32 + hi * 16); \
                kf[2 * c + 1] = *(LAS bf16x8*)(Kb + (32 + r32) * KP + comp * 128 + c * 32 + hi * 16); } \
            __builtin_amdgcn_sched_barrier(0); \
            s0 = negm; s1 = negm; \
            if (!DIFF) {       \
                ka0 = *(LAS bf16x8*)(Kb + r32 * KP + 128); ka1 = *(LAS bf16x8*)(Kb + (32 + r32) * KP + 128); \
                unsigned h_, m_, l_; split3(cq - pref[kt], h_, m_, l_); \
                u32x4 qa_ = (u32x4){0x3f803f80u, 0x3f80u | (h_ << 16), m_ | (l_ << 16), 0u}; \
                if (hi) qa_ = (u32x4){0u, 0u, 0u, 0u}; \
                qa = __builtin_bit_cast(bf16x8, qa_); } \
            __builtin_amdgcn_s_setprio(1); \
            if (!DIFF) { s0 = __builtin_amdgcn_mfma_f32_32x32x16_bf16(ka0, qa, s0, 0, 0, 0); s1 = __builtin_amdgcn_mfma_f32_32x32x16_bf16(ka1, qa, s1, 0, 0, 0); } \
            _Pragma("unroll") for (int c = 0; c < 4; ++c) { \
                s0 = __builtin_amdgcn_mfma_f32_32x32x16_bf16(kf[2 * c], qf[c], s0, 0, 0, 0); \
                s1 = __builtin_amdgcn_mfma_f32_32x32x16_bf16(kf[2 * c + 1], qf[c], s1, 0, 0, 0); } \
            __builtin_amdgcn_s_setprio(0); } while (0)
#define MASK_BLOCK() do { if (kt == 0 || kt >= diag0) { \
            _Pragma("unroll") for (int r = 0; r < 16; ++r) { const int kpp = 64 * kt + crow(r, hi); \
                if (kpp < 48 || kpp > q_pp) s0[r] = -INFINITY; \
                if (kpp + 32 < 48 || kpp + 32 > q_pp) s1[r] = -INFINITY; } } } while (0)
#define EXPSUM_BLOCK() do { psa = 0.f; psb = 0.f; \
            _Pragma("unroll") for (int r = 0; r < 16; ++r) { s0[r] = __builtin_amdgcn_exp2f(s0[r]); s1[r] = __builtin_amdgcn_exp2f(s1[r]); psa += s0[r]; asm("" : "+v"(psa)); psb += s1[r]; asm("" : "+v"(psb)); } } while (0)
            QK_BLOCK();
            s16x4 vlo[8], vhi[8];
#pragma unroll
            for (int t = 0; t < 2; ++t)
#pragma unroll
                for (int j = 0; j < 4; ++j) { vlo[t * 4 + j] = vtr(Vb + trb + (16 * j) * VP + t * 64); vhi[t * 4 + j] = vtr(Vb + trb + (16 * j + 8) * VP + t * 64); }
            __builtin_amdgcn_sched_barrier(0);
            MASK_BLOCK();
            bool full = (kt == kt0);
            float psa, psb;
            if (!full) {
                EXPSUM_BLOCK();
                if (__any(psa + psb > 1.0e18f)) { full = true; QK_BLOCK();
#pragma unroll
                    for (int t = 0; t < 2; ++t)
#pragma unroll
                        for (int j = 0; j < 4; ++j) { vlo[t * 4 + j] = vtr(Vb + trb + (16 * j) * VP + t * 64); vhi[t * 4 + j] = vtr(Vb + trb + (16 * j + 8) * VP + t * 64); }
                    MASK_BLOCK(); }
            }
            if (full) {
                float ma = fmaxf(fmaxf(s0[0], s0[1]), s1[0]), mb = fmaxf(fmaxf(s0[2], s0[3]), s1[1]);
                ma = fmaxf(fmaxf(ma, s1[2]), s1[3]);
#pragma unroll
                for (int r = 4; r < 16; r += 4) { ma = fmaxf(fmaxf(ma, s0[r]), s0[r + 1]); mb = fmaxf(fmaxf(mb, s0[r + 2]), s0[r + 3]); ma = fmaxf(fmaxf(ma, s1[r]), s1[r + 1]); mb = fmaxf(fmaxf(mb, s1[r + 2]), s1[r + 3]); }
                const float rm = swap32_max(fmaxf(ma, mb));
                const float dl = (kt == kt0) ? ((rm == -INFINITY) ? 0.f : rm) : fmaxf(rm, 0.f);
                mhat += dl;
#pragma unroll
                for (int r = 0; r < 16; ++r) { s0[r] -= dl; s1[r] -= dl; negm[r] = -mhat; }
                const float f = (kt == kt0) ? 1.0f : __builtin_amdgcn_exp2f(-dl);
                l_run *= f;
#pragma unroll
                for (int t = 0; t < NTD; ++t)
#pragma unroll
                    for (int r = 0; r < 16; ++r) o[t][r] *= f;
                EXPSUM_BLOCK();
            }
            l_run += psa + psb;
#undef QK_BLOCK
#undef MASK_BLOCK
#undef EXPSUM_BLOCK
            bf16x8 pw[4];
#pragma unroll
            for (int j = 0; j < 4; ++j) {
                u32x4 pk;
                if (j < 2) { const int rb = 8 * (j & 1); pk.x = cvtpk(s0[rb], s0[rb + 1]); pk.y = cvtpk(s0[rb + 2], s0[rb + 3]); pk.z = cvtpk(s0[rb + 4], s0[rb + 5]); pk.w = cvtpk(s0[rb + 6], s0[rb + 7]); }
                else { const int rb = 8 * (j & 1); pk.x = cvtpk(s1[rb], s1[rb + 1]); pk.y = cvtpk(s1[rb + 2], s1[rb + 3]); pk.z = cvtpk(s1[rb + 4], s1[rb + 5]); pk.w = cvtpk(s1[rb + 6], s1[rb + 7]); }
                pw[j] = __builtin_bit_cast(bf16x8, pk);
            }
            __builtin_amdgcn_sched_barrier(0);
            __builtin_amdgcn_s_setprio(1);
#pragma unroll
            for (int t = 0; t < 2; ++t)
#pragma unroll
                for (int j = 0; j < 4; ++j) {
                    const bf16x8 vf = (bf16x8){vlo[t * 4 + j][0], vlo[t * 4 + j][1], vlo[t * 4 + j][2], vlo[t * 4 + j][3], vhi[t * 4 + j][0], vhi[t * 4 + j][1], vhi[t * 4 + j][2], vhi[t * 4 + j][3]};
                    o[t] = __builtin_amdgcn_mfma_f32_32x32x16_bf16(vf, pw[j], o[t], 0, 0, 0);
                }
            if (DIFF) {
#pragma unroll
                for (int t = 2; t < NTD; ++t)
#pragma unroll
                    for (int j = 0; j < 4; ++j) { vlo[(t - 2) * 4 + j] = vtr(Vb + trb + (16 * j) * VP + t * 64); vhi[(t - 2) * 4 + j] = vtr(Vb + trb + (16 * j + 8) * VP + t * 64); }
                __builtin_amdgcn_sched_barrier(0);
#pragma unroll
                for (int t = 2; t < NTD; ++t)
#pragma unroll
                    for (int j = 0; j < 4; ++j) {
                        const int i = (t - 2) * 4 + j;
                        const bf16x8 vf = (bf16x8){vlo[i][0], vlo[i][1], vlo[i][2], vlo[i][3], vhi[i][0], vhi[i][1], vhi[i][2], vhi[i][3]};
                        o[t] = __builtin_amdgcn_mfma_f32_32x32x16_bf16(vf, pw[j], o[t], 0, 0, 0);
                    }
            }
            __builtin_amdgcn_s_setprio(0);
        }
        if (kt + 1 < nt) STORE_TILE((kt + 1) & 1);
        __syncthreads();
    }
#undef LOAD_TILE
#undef STORE_TILE
    const float lt = swap32_sum(l_run);
    const float inv = lt > 0.f ? 1.0f / lt : 0.f;
    const size_t Rq = Rb + q_pp;
    bf16* mrow = (qi != 0) ? A.mixed + ((size_t)b * T + (q_pp - 64)) * DM : A.mixm + (size_t)((q_pp - 48) & 15) * DM;
    if (!DIFF) {
        if (store_ok) {
#pragma unroll
            for (int t = 0; t < NTD; ++t)
#pragma unroll
                for (int g = 0; g < 4; ++g) {
                    const int dv0 = 32 * t + 8 * g + 4 * hi;
                    const u32x2 z = *(const u32x2*)(A.P + Rq * NP + zcol + dv0);
                    u32x2 wv; wv.x = cvtpk(o[t][4 * g] * inv * bf_lo(z.x), o[t][4 * g + 1] * inv * bf_hi(z.x)); wv.y = cvtpk(o[t][4 * g + 2] * inv * bf_lo(z.y), o[t][4 * g + 3] * inv * bf_hi(z.y));
                    *(u32x2*)(mrow + mcol + dv0) = wv;
                }
        }
    } else {
        LAS float* xch = (LAS float*)lds;
        if (comp == 1) {
            const float f = inv * A.lam;
#pragma unroll
            for (int t = 0; t < NTD; ++t)
#pragma unroll
                for (int r = 0; r < 16; ++r) xch[(t * 16 + r) * 256 + wq * 64 + lane] = o[t][r] * f;
        }
        __syncthreads();
        if (comp == 0) {
            float ss = 0.f;
#pragma unroll
            for (int t = 0; t < NTD; ++t)
#pragma unroll
                for (int r = 0; r < 16; ++r) { const float v = o[t][r] * inv - xch[(t * 16 + r) * 256 + wq * 64 + lane]; o[t][r] = v; ss += v * v; }
            ss = swap32_sum(ss);
            const float rn = rsqrtf(ss * (1.0f / 128.0f) + NORM_EPS) * A.one_m_li;
            if (store_ok) {
#pragma unroll
                for (int t = 0; t < NTD; ++t)
#pragma unroll
                    for (int g = 0; g < 4; ++g) {
                        const int dv0 = 32 * t + 8 * g + 4 * hi;
                        const u32x2 z = *(const u32x2*)(A.P + Rq * NP + zcol + dv0);
                        const f32x4 sg = *(const f32x4*)(A.subg + h * 128 + dv0);
                        u32x2 wv; wv.x = cvtpk(o[t][4 * g] * rn * sg[0] * bf_lo(z.x), o[t][4 * g + 1] * rn * sg[1] * bf_hi(z.x));
                        wv.y = cvtpk(o[t][4 * g + 2] * rn * sg[2] * bf_lo(z.y), o[t][4 * g + 3] * rn * sg[3] * bf_hi(z.y));
                        *(u32x2*)(mrow + mcol + dv0) = wv;
                    }
            }
        }
        __syncthreads();
    }
}

__device__ __forceinline__ void attn_phase(Frame& F, int layer, int rep) {
    AttnP A; A.P = F.P; A.mixed = F.mix; A.cumloc = F.cumloc; A.cumtot = F.cumtot; A.subg = F.subln_g + layer * 512; A.nrm = F.ctl + 128 + layer * 128; A.mixm = F.mixm;
    A.lam = F.lam[layer]; A.one_m_li = 1.0f - (0.8f - 0.6f * expf(-0.3f * (float)layer));
    LAS int* cur = (LAS int*)(F.lds + LDS_MISC);
    unsigned* counter = F.ctl + 16 * (layer + 1) + 4 * rep;
    for (;;) {
        if (F.tid == 0) *cur = (int)atomicAdd(counter, 1u);
        __syncthreads();
        const int idx = *cur;
        __syncthreads();
        if (idx >= N_UNITS) break;
        const int u = F.units[layer * N_UNITS + idx];
        if (u < N_DIFF_UNITS) {
#ifndef NO_DIFF
            const int bh = u / 65, qi = u % 65; attn_unit<true>(A, bh >> 2, bh & 3, qi, F.lds);
#endif
        }
#ifndef NO_FOX
        else { const int v = u - N_DIFF_UNITS; const int bh = v / 33, qi = v % 33; attn_unit<false>(A, bh >> 3, bh & 7, qi, F.lds); }
#endif
    }
}

__device__ __forceinline__ void final_phase(Frame& F) {
    const int gw = F.bid * 8 + F.wave, NGW = F.G * 8;
    for (int m = gw; m < NB * T; m += NGW) {
        const float rs = rsqrtf(F.sumsq[2 * MG + m] * (1.0f / DM) + NORM_EPS);
        float* p = F.out + (size_t)m * DM;
#pragma unroll
        for (int j = 0; j < 4; ++j) { const f32x4 v = *(const f32x4*)(p + 4 * F.lane + 256 * j); const f32x4 g = *(const f32x4*)(F.final_g + 4 * F.lane + 256 * j); *(f32x4*)(p + 4 * F.lane + 256 * j) = v * rs * g; }
    }
}

#define XB_TMO      128
#define XB_XCNT(j)  (256  + 64 * (j))
#define XB_XSUB(j)  (1280 + 64 * (j))
#define XB_XGEN(j)  (2304 + 64 * (j))
#define XB_TOP      3328
#define XB_TOPGEN   3392
#define XCD_BAR_WORDS 3456
#define XB_SPIN_CAP (1u << 18)

__device__ __forceinline__ unsigned xb_ld(unsigned* p)              { return __hip_atomic_load(p, __ATOMIC_RELAXED, __HIP_MEMORY_SCOPE_AGENT); }
__device__ __forceinline__ unsigned xb_add(unsigned* p, unsigned v) { return __hip_atomic_fetch_add(p, v, __ATOMIC_RELAXED, __HIP_MEMORY_SCOPE_AGENT); }
__device__ __forceinline__ unsigned xb_xcc_id() { return (unsigned)__builtin_amdgcn_s_getreg((3 << 11) | 20) & 0xFu; }
#define XB_SPIN(cond, bar) do { unsigned _sp = 0; while (cond) { __builtin_amdgcn_s_sleep(1); \
    if ((++_sp & 255u) == 0u) { if (xb_ld(&(bar)[XB_TMO])) break; if (_sp > XB_SPIN_CAP) { atomicAdd(&(bar)[XB_TMO], 1u); break; } } } } while (0)

struct XcdBarrier {
    unsigned* bar; unsigned x;
    volatile LAS unsigned* st;
};

__device__ __forceinline__ XcdBarrier xcd_barrier_post(unsigned* bar, volatile LAS unsigned* st) {
    XcdBarrier b; b.bar = bar; b.x = xb_xcc_id(); b.st = st;
    if (threadIdx.x == 0) (void)xb_add(&bar[XB_XCNT(b.x)], 1u);
    return b;
}
__device__ __forceinline__ void xcd_barrier_complete(unsigned* bar, unsigned x, unsigned& nloc, unsigned& nx) {
    const unsigned G = gridDim.x * gridDim.y * gridDim.z;
    unsigned sum, cnt, mine, sp = 0u;
    for (;;) {
        sum = 0u; cnt = 0u; mine = 0u;
#pragma unroll
        for (unsigned j = 0; j < 16; ++j) { const unsigned c = xb_ld(&bar[XB_XCNT(j)]); sum += c; cnt += (c > 0u) ? 1u : 0u; mine = (j == x) ? c : mine; }
        if (sum == G) break;
        __builtin_amdgcn_s_sleep(1);
        if ((++sp & 255u) == 0u) { if (xb_ld(&bar[XB_TMO])) break; if (sp > XB_SPIN_CAP) { atomicAdd(&bar[XB_TMO], 1u); break; } }
    }
    nloc = mine > 0u ? mine : 1u; nx = cnt > 0u ? cnt : 1u;
}

__device__ __forceinline__ void xcd_barrier(const XcdBarrier& b) {
    asm volatile("s_waitcnt vmcnt(0)" ::: "memory");
    __syncthreads();
    if (threadIdx.x == 0) {
        unsigned* bar = b.bar;
        __builtin_amdgcn_s_waitcnt(0);
        unsigned nloc = b.st[0], nx = b.st[1];
        if (nloc == 0u) { xcd_barrier_complete(bar, b.x, nloc, nx); b.st[0] = nloc; b.st[1] = nx; }
        const unsigned old = xb_add(&bar[XB_XSUB(b.x)], 1u);
        const unsigned gen = old / nloc;
        if (old + 1u == (gen + 1u) * nloc) {
            __builtin_amdgcn_fence(__ATOMIC_RELEASE, "agent");
            asm volatile("s_waitcnt vmcnt(0)" ::: "memory");
            const unsigned og = xb_add(&bar[XB_TOP], 1u);
            const unsigned tg = og / nx;
            if (og + 1u == (tg + 1u) * nx) xb_add(&bar[XB_TOPGEN], 1u);
            else XB_SPIN(xb_ld(&bar[XB_TOPGEN]) == tg, bar);
            __builtin_amdgcn_fence(__ATOMIC_ACQUIRE, "agent");
            xb_add(&bar[XB_XGEN(b.x)], 1u);
            asm volatile("s_waitcnt vmcnt(0)" ::: "memory");
        } else {
            XB_SPIN(xb_ld(&bar[XB_XGEN(b.x)]) == gen, bar);
            __builtin_amdgcn_fence(__ATOMIC_ACQUIRE, "agent");
            asm volatile("s_waitcnt vmcnt(0)" ::: "memory");
        }
    }
    __syncthreads();
}

struct Args { const float* in[12]; float* out; unsigned char* ws; int ph_lo, ph_hi; };
typedef const __attribute__((address_space(4))) Args* kargp;
__device__ __forceinline__ void make_frame(Frame& F, ldsp lds) {
    kargp ap = (kargp)__builtin_amdgcn_kernarg_segment_ptr();
    asm volatile("" : "+s"(ap));
    int tid = threadIdx.x; asm volatile("" : "+v"(tid));
    F.lds = lds; F.tid = tid; F.lane = tid & 63; F.wave = __builtin_amdgcn_readfirstlane(tid >> 6); F.G = gridDim.x; F.bid = blockIdx.x;
    F.x = ap->in[0]; F.meta = ap->in[1]; F.norm_g = ap->in[2]; F.w_in = ap->in[3]; F.b_forget = ap->in[4]; F.lq1 = ap->in[5]; F.lk1 = ap->in[6]; F.lq2 = ap->in[7]; F.lk2 = ap->in[8];
    F.subln_g = ap->in[9]; F.w_out = ap->in[10]; F.final_g = ap->in[11]; F.out = ap->out; F.ws = ap->ws;
    unsigned char* ws = ap->ws;
    F.ctl = (unsigned*)(ws + WS_CTL); F.lam = (float*)(ws + WS_LAM); F.units = (int*)(ws + WS_UNITS); F.sumsq = (float*)(ws + WS_SUMSQ); F.cumtot = (float*)(ws + WS_CUMTOT); F.cumloc = (float*)(ws + WS_CUMLOC);
    F.hside = (float*)(ws + WS_HSIDE); F.rope = (float*)(ws + WS_ROPE); F.win_t = (bf16*)(ws + WS_WIN); F.wout_t = (bf16*)(ws + WS_WOUT); F.hb = (bf16*)(ws + WS_HB); F.mix = (bf16*)(ws + WS_MIX); F.P = (bf16*)(ws + WS_P); F.mixm = (bf16*)(ws + WS_HSIDE + 128 * 1024);
}
__global__ void __launch_bounds__(512) hymba_fwd(Args args) {
    extern __shared__ __attribute__((aligned(16))) unsigned char lds_raw[];
    const ldsp lds = (ldsp)lds_raw;
    const int lo = args.ph_lo, hi = args.ph_hi;
    const bool fuse_final = (lo == 0 && hi == 8 && gridDim.x == 256);
    volatile LAS unsigned* bst = (volatile LAS unsigned*)(lds + LDS_MISC + 128);
    if (threadIdx.x < 2) bst[threadIdx.x] = 0u;
    __syncthreads();
    XcdBarrier xbar; xbar.bar = (unsigned*)(args.ws + WS_BAR); xbar.x = 0; xbar.st = bst;
    if (hi - lo > 1) xbar = xcd_barrier_post((unsigned*)(args.ws + WS_BAR), bst);
    if (lo < 0) cg::this_grid().sync();
#define IN(k) (lo <= (k) && (k) < hi)
#define SEAM(k) do { if (IN(k) && IN((k) + 1)) { xcd_barrier(xbar); } } while (0)
#ifndef REP_PRO
#define REP_PRO 1
#endif
#ifndef REP_IN
#define REP_IN 1
#endif
#ifndef REP_ATTN
#define REP_ATTN 1
#endif
    if (IN(0)) { for (int rep = 0; rep < REP_PRO; ++rep) { Frame F; make_frame(F, lds); p0_prologue(F); if (rep + 1 < REP_PRO) xcd_barrier(xbar); } }
    SEAM(0);
#pragma unroll 1
    for (int layer = 0; layer < 2; ++layer) {
        const int pb = 1 + 3 * layer;
        if (IN(pb)) { for (int rep = 0; rep < REP_IN; ++rep) {
#ifndef NO_FORGET
            { Frame F; make_frame(F, lds); for (int tile = F.bid; tile < MG / 64; tile += F.G) forget_item(F, layer, tile);
              for (int it = F.G - 1 - F.bid; it < 257; it += F.G) meta_item<0>(F, layer, it); }
#endif
#ifndef NO_GIN
            { Frame F; make_frame(F, lds);
              pg8::Gemm g{F.hb, F.win_t + (size_t)layer * NP * DM, MG, NP, DM}; pg8::StaticOrder S; S.init(MG, NP, F.G, F.bid);
              pg8::EpiIn E{F.P, F.sumsq + layer * MG, F.rope, F.ctl + 128 + layer * 128};
              pg8::gemm_phase<pg8::EpiIn, pg8::StaticOrder, true, true>(F.lds, g, S, E); }
#endif
        } }
        SEAM(pb);
        if (IN(pb + 1)) { for (int rep = 0; rep < REP_ATTN; ++rep) { Frame F; make_frame(F, lds); attn_phase(F, layer, rep); } }
        SEAM(pb + 1);
        if (IN(pb + 2)) {
#ifndef NO_GOUT
            Frame F; make_frame(F, lds);
            if (layer == 0) { for (int it = F.bid; it < DM / 16; it += F.G) meta_item<1>(F, layer, it); }
            pg8::Gemm g{F.mix, F.wout_t + (size_t)layer * DM * DM, MG, DM, DM}; pg8::StaticOrder S; S.init(MG, DM, F.G, F.bid);
            if (layer == 1 && fuse_final) {
                pg8::EpiOutFinal E{(const float*)F.out, F.out, F.sumsq + 2 * MG, F.ctl + 448, F.final_g};
                pg8::gemm_phase<pg8::EpiOutFinal, pg8::StaticOrder, true, true>(F.lds, g, S, E);
            } else {
                pg8::EpiOut E{layer == 0 ? F.x : (const float*)F.out, F.out, F.hb, F.sumsq + (layer + 1) * MG, layer == 0 ? 1 : 0};
                pg8::gemm_phase<pg8::EpiOut, pg8::StaticOrder, true, true>(F.lds, g, S, E);
            }
#endif
        }
        if (!(layer == 1 && fuse_final)) SEAM(pb + 2);
    }
    if (IN(7) && !fuse_final) { Frame F; make_frame(F, lds); final_phase(F); }
#undef IN
#undef SEAM
}

extern "C" void kernel_launch(void* const* d_in, const int* in_sizes, int n_in, void* d_out, int out_size, void* d_ws, size_t ws_size, hipStream_t stream) {
    static int grid = 0;
    if (grid == 0) {
        if (n_in != 12 || out_size != NB * T * DM || ws_size < WS_END) { fprintf(stderr, "kernel_launch: unexpected shapes (n_in %d out %d ws %zu)\n", n_in, out_size, ws_size); grid = -1; return; }
        int dev = 0, cus = 0, per_cu = 0;
        (void)hipGetDevice(&dev); (void)hipDeviceGetAttribute(&cus, hipDeviceAttributeMultiprocessorCount, dev);
        if (hipFuncSetAttribute((const void*)hymba_fwd, hipFuncAttributeMaxDynamicSharedMemorySize, LDS_BYTES) != hipSuccess) { fprintf(stderr, "kernel_launch: hipFuncSetAttribute failed\n"); grid = -1; return; }
        if (hipOccupancyMaxActiveBlocksPerMultiprocessor(&per_cu, (const void*)hymba_fwd, 512, LDS_BYTES) != hipSuccess || per_cu < 1) per_cu = 1;
        (void)hipGetLastError();
        grid = cus * per_cu;
        if (grid <= 0) grid = 256;
    }
    if (grid < 0) return;
    Args a{};
    for (int i = 0; i < 12; ++i) a.in[i] = (const float*)d_in[i];
    a.out = (float*)d_out; a.ws = (unsigned char*)d_ws;
#if MK_SINGLE
    (void)hipMemsetAsync((unsigned char*)d_ws + WS_BAR, 0, 16384, stream);
    a.ph_lo = 0; a.ph_hi = 8;
    void* kargs[] = {&a};
    hipError_t e = hipLaunchCooperativeKernel((const void*)hymba_fwd, dim3(grid), dim3(512), kargs, LDS_BYTES, stream);
    if (e != hipSuccess) fprintf(stderr, "cooperative launch failed: %s (grid %d)\n", hipGetErrorString(e), grid);
#else
    for (int p = 0; p < 8; ++p) {
        a.ph_lo = p; a.ph_hi = p + 1;
        hipLaunchKernelGGL(hymba_fwd, dim3(grid), dim3(512), LDS_BYTES, stream, a);
    }
#endif
}
```
